# Optimizing an MI355X kernel written in HIP

```python
import math
import jax, jax.numpy as jnp
from jax import lax
import numpy as np

D_MODEL = 1024
BATCH = 8
SEQ = 2048
DEPTH = 1
DEC_BATCH = 16
DEC_SEQ = 2048
PAST_LEN = 128

MIX_WIDTH = D_MODEL
RET_WIDTH = MIX_WIDTH // 2
SSM_WIDTH = MIX_WIDTH - RET_WIDTH
RET_HEADS = 4
RET_HEAD_DIM = RET_WIDTH // RET_HEADS
RET_CHUNK = 128
ROPE_BASE = 10000.0
SSM_GROUP = 16
SSM_GROUPS = SSM_WIDTH // SSM_GROUP
SSM_STATE = 64
DT_MIN = 1e-3
DT_MAX = 1e-1
D_FF = 2816
CONV_WIDTH = 3
EPS = 1e-6
IN_WIDTH = 4 * RET_WIDTH + SSM_WIDTH

kernel_name = "hybrid_retention_s5_encoder"


def _rms_norm(x, g):
    xf = x.astype(jnp.float32)
    y = xf * lax.rsqrt(jnp.mean(xf * xf, axis=-1, keepdims=True) + EPS)
    return (y * g.astype(jnp.float32)).astype(x.dtype)


def _rotary(x, pos):
    half = x.shape[-1] // 2
    inv_freq = ROPE_BASE ** (-jnp.arange(half, dtype=jnp.float32) / half)
    ang = pos[:, None] * inv_freq[None, :]
    cos = jnp.cos(ang)[None, :, None, :]
    sin = jnp.sin(ang)[None, :, None, :]
    x1, x2 = x[..., :half], x[..., half:]
    return jnp.concatenate([x1 * cos - x2 * sin, x1 * sin + x2 * cos], axis=-1)


def _retention_one_direction(q, k, v, log_gamma, strict):
    b, h, l, dh = q.shape
    n = l // RET_CHUNK
    c = RET_CHUNK
    qc = q.reshape(b, h, n, c, dh)
    kc = k.reshape(b, h, n, c, dh)
    vc = v.reshape(b, h, n, c, dh)
    idx = jnp.arange(c, dtype=jnp.float32)
    diff = idx[:, None] - idx[None, :]
    mask = (diff > 0) if strict else (diff >= 0)
    lg = log_gamma[:, None, None]
    inner_decay = jnp.where(mask[None], jnp.exp(lg * jnp.maximum(diff, 0.0)[None]), 0.0)
    scores = jnp.einsum('bhncd,bhnmd->bhncm', qc, kc) * inner_decay[None, :, None]
    inner = jnp.einsum('bhncm,bhnme->bhnce', scores, vc)
    zeta = jnp.exp(log_gamma[:, None] * (c - 1.0 - idx)[None, :])
    kv = jnp.einsum('bhncd,bhnce->nbhde', kc * zeta[None, :, None, :, None], vc)
    chunk_decay = jnp.exp(log_gamma * c)[None, :, None, None]

    def step(r, kv_n):
        return chunk_decay * r + kv_n, r

    _, r_prev = lax.scan(step, jnp.zeros((b, h, dh, dh), jnp.float32), kv)
    xi = jnp.exp(log_gamma[:, None] * (idx + 1.0)[None, :])
    cross = jnp.einsum('bhncd,nbhde->bhnce', qc, r_prev) * xi[None, :, None, :, None]
    return (inner + cross).reshape(b, h, l, dh)


def _retention(q, k, v, g, gn_gain):
    b, l, _ = q.shape
    pos = jnp.arange(l, dtype=jnp.float32)
    qh = _rotary(q.astype(jnp.float32).reshape(b, l, RET_HEADS, RET_HEAD_DIM), pos)
    kh = _rotary(k.astype(jnp.float32).reshape(b, l, RET_HEADS, RET_HEAD_DIM), pos) * (RET_HEAD_DIM ** -0.5)
    vh = v.astype(jnp.float32).reshape(b, l, RET_HEADS, RET_HEAD_DIM)
    qh, kh, vh = (t.transpose(0, 2, 1, 3) for t in (qh, kh, vh))
    log_gamma = jnp.log(1.0 - 2.0 ** (-5.0 - jnp.arange(RET_HEADS, dtype=jnp.float32)))
    fwd = _retention_one_direction(qh, kh, vh, log_gamma, False)
    bwd = jnp.flip(_retention_one_direction(jnp.flip(qh, 2), jnp.flip(kh, 2), jnp.flip(vh, 2),
                                            log_gamma, True), 2)
    o = (fwd + bwd).transpose(0, 2, 1, 3)
    o = o * lax.rsqrt(jnp.mean(o * o, axis=-1, keepdims=True) + EPS)
    o = o.reshape(b, l, RET_WIDTH) * gn_gain.astype(jnp.float32)
    return (jax.nn.silu(g.astype(jnp.float32)) * o).astype(q.dtype)


def _complex_scan_combine(e1, e2):
    a1r, a1i, b1r, b1i = e1
    a2r, a2i, b2r, b2i = e2
    ar = a2r * a1r - a2i * a1i
    ai = a2r * a1i + a2i * a1r
    br = a2r * b1r - a2i * b1i + b2r
    bi = a2r * b1i + a2i * b1r + b2i
    return (ar, ai, br, bi)


def _s5(u, lam_re, lam_im, log_dt, b_re, b_im, c_re, c_im, d_skip, glu_w, glu_b):
    bsz, l, _ = u.shape
    uf = u.astype(jnp.float32)
    ug = uf.reshape(bsz, l, SSM_GROUPS, SSM_GROUP)
    y = d_skip.astype(jnp.float32) * uf
    for d in range(2):
        lr = jnp.minimum(lam_re[d].astype(jnp.float32), -1e-4)
        li = lam_im[d].astype(jnp.float32)
        dt = jnp.exp(log_dt[d].astype(jnp.float32))[:, None]
        mag = jnp.exp(lr * dt)
        ar = mag * jnp.cos(li * dt)
        ai = mag * jnp.sin(li * dt)
        den = lr * lr + li * li
        nr = ar - 1.0
        ni = ai
        cr = (nr * lr + ni * li) / den
        ci = (ni * lr - nr * li) / den
        br_ = b_re[d].astype(jnp.float32)
        bi_ = b_im[d].astype(jnp.float32)
        bbr = cr[..., None] * br_ - ci[..., None] * bi_
        bbi = cr[..., None] * bi_ + ci[..., None] * br_
        bu_r = jnp.einsum('blgc,gnc->blgn', ug, bbr)
        bu_i = jnp.einsum('blgc,gnc->blgn', ug, bbi)
        a_r = jnp.broadcast_to(ar, bu_r.shape)
        a_i = jnp.broadcast_to(ai, bu_i.shape)
        _, _, xr, xi = lax.associative_scan(_complex_scan_combine, (a_r, a_i, bu_r, bu_i),
                                            axis=1, reverse=(d == 1))
        yd = (jnp.einsum('blgn,gcn->blgc', xr, c_re[d].astype(jnp.float32))
              - jnp.einsum('blgn,gcn->blgc', xi, c_im[d].astype(jnp.float32)))
        y = y + yd.reshape(bsz, l, SSM_WIDTH)
    y = jax.nn.gelu(y)
    gate = jax.nn.sigmoid(y @ glu_w.astype(jnp.float32) + glu_b.astype(jnp.float32))
    return (y * gate).astype(u.dtype)


def _conv_ffn(h, w_up, conv_w, conv_b, w_down):
    z = h @ w_up
    zp = jnp.pad(z, ((0, 0), (1, 1), (0, 0)))
    z = zp[:, :-2] * conv_w[0] + zp[:, 1:-1] * conv_w[1] + zp[:, 2:] * conv_w[2] + conv_b
    val, gate = jnp.split(z, 2, axis=-1)
    return (jax.nn.gelu(gate) * val) @ w_down


def _trunk(x, norm_mix, w_in, ret_gn_gain, s5_lambda_re, s5_lambda_im, s5_log_dt,
           s5_B_re, s5_B_im, s5_C_re, s5_C_im, s5_D, s5_glu_w, s5_glu_b, w_out,
           norm_ffn, w_up, conv_w, conv_b, w_down, norm_final):
    for i in range(DEPTH):
        h = _rms_norm(x, norm_mix[i])
        proj = h @ w_in[i]
        q, k, v, g, u = jnp.split(proj, [RET_WIDTH, 2 * RET_WIDTH, 3 * RET_WIDTH, 4 * RET_WIDTH], axis=-1)
        ret = _retention(q, k, v, g, ret_gn_gain[i])
        ssm = _s5(u, s5_lambda_re[i], s5_lambda_im[i], s5_log_dt[i], s5_B_re[i], s5_B_im[i],
                  s5_C_re[i], s5_C_im[i], s5_D[i], s5_glu_w[i], s5_glu_b[i])
        x = x + jnp.concatenate([ret, ssm], axis=-1) @ w_out[i]
        h = _rms_norm(x, norm_ffn[i])
        x = x + _conv_ffn(h, w_up[i], conv_w[i], conv_b[i], w_down[i])
    return _rms_norm(x, norm_final)


def setup_inputs(seed: int = 0) -> dict:
    key = jax.random.key(seed)
    ks = jax.random.split(key, 24)
    f32 = jnp.float32
    nrm = lambda k, s, sc: jax.random.normal(k, s, f32) * sc
    n_idx = jnp.arange(SSM_STATE, dtype=f32)
    sdir = (DEPTH, 2, SSM_GROUPS)
    return {
        "x_prompt": jax.random.normal(ks[0], (BATCH, SEQ, D_MODEL), f32),
        "x_sample": jax.random.normal(ks[1], (DEC_BATCH, DEC_SEQ, D_MODEL), f32),
        "norm_mix": 1.0 + nrm(ks[2], (DEPTH, D_MODEL), 0.02),
        "w_in": nrm(ks[3], (DEPTH, D_MODEL, IN_WIDTH), D_MODEL ** -0.5),
        "ret_gn_gain": 1.0 + nrm(ks[4], (DEPTH, RET_WIDTH), 0.02),
        "s5_lambda_re": -0.5 + nrm(ks[5], sdir + (SSM_STATE,), 0.01),
        "s5_lambda_im": math.pi * n_idx + nrm(ks[6], sdir + (SSM_STATE,), 0.01),
        "s5_log_dt": jax.random.uniform(ks[7], sdir, f32, math.log(DT_MIN), math.log(DT_MAX)),
        "s5_B_re": nrm(ks[8], sdir + (SSM_STATE, SSM_GROUP), (2 * SSM_GROUP) ** -0.5),
        "s5_B_im": nrm(ks[9], sdir + (SSM_STATE, SSM_GROUP), (2 * SSM_GROUP) ** -0.5),
        "s5_C_re": nrm(ks[10], sdir + (SSM_GROUP, SSM_STATE), SSM_STATE ** -0.5),
        "s5_C_im": nrm(ks[11], sdir + (SSM_GROUP, SSM_STATE), SSM_STATE ** -0.5),
        "s5_D": nrm(ks[12], (DEPTH, SSM_WIDTH), 1.0),
        "s5_glu_w": nrm(ks[13], (DEPTH, SSM_WIDTH, SSM_WIDTH), SSM_WIDTH ** -0.5),
        "s5_glu_b": nrm(ks[14], (DEPTH, SSM_WIDTH), 0.01),
        "w_out": nrm(ks[15], (DEPTH, MIX_WIDTH, D_MODEL), MIX_WIDTH ** -0.5),
        "norm_ffn": 1.0 + nrm(ks[16], (DEPTH, D_MODEL), 0.02),
        "w_up": nrm(ks[17], (DEPTH, D_MODEL, 2 * D_FF), D_MODEL ** -0.5),
        "conv_w": nrm(ks[18], (DEPTH, CONV_WIDTH, 2 * D_FF), CONV_WIDTH ** -0.5),
        "conv_b": nrm(ks[19], (DEPTH, 2 * D_FF), 0.01),
        "w_down": nrm(ks[20], (DEPTH, D_FF, D_MODEL), D_FF ** -0.5),
        "norm_final": 1.0 + nrm(ks[21], (D_MODEL,), 0.02),
    }


def reference(x_prompt, x_sample, norm_mix, w_in, ret_gn_gain, s5_lambda_re, s5_lambda_im,
              s5_log_dt, s5_B_re, s5_B_im, s5_C_re, s5_C_im, s5_D, s5_glu_w, s5_glu_b,
              w_out, norm_ffn, w_up, conv_w, conv_b, w_down, norm_final):
    y_prompt = _trunk(x_prompt, norm_mix, w_in, ret_gn_gain, s5_lambda_re, s5_lambda_im,
                      s5_log_dt, s5_B_re, s5_B_im, s5_C_re, s5_C_im, s5_D, s5_glu_w, s5_glu_b,
                      w_out, norm_ffn, w_up, conv_w, conv_b, w_down, norm_final)
    y_sample = _trunk(x_sample, norm_mix, w_in, ret_gn_gain, s5_lambda_re, s5_lambda_im,
                      s5_log_dt, s5_B_re, s5_B_im, s5_C_re, s5_C_im, s5_D, s5_glu_w, s5_glu_b,
                      w_out, norm_ffn, w_up, conv_w, conv_b, w_down, norm_final)
    return (y_prompt, y_sample)
```

```cpp
#include <hip/hip_runtime.h>
#include <cstdio>
#include <cstdint>

#ifndef MK_N_LAUNCHES
#define MK_N_LAUNCHES 11
#endif

namespace pg8 {
#define PG8_LAS __attribute__((address_space(3)))
typedef unsigned short bf16_t;
typedef short bf16x8 __attribute__((ext_vector_type(8)));
typedef float f32x4 __attribute__((ext_vector_type(4)));
typedef unsigned u32x4 __attribute__((ext_vector_type(4)));
typedef unsigned u32x2 __attribute__((ext_vector_type(2)));
constexpr int BM = 256, BK = 64, HALF = 128, HTB = HALF * BK * 2, STAGE_BYTES = 8 * HTB, NXCD = 8, WGM = 8;

__host__ __device__ __forceinline__ int lds_byte(int r, int c) { const int st = (r >> 4) * 2 + (c >> 5), rr = r & 15, cc = c & 31, ob = rr * 64 + cc * 2; return st * 1024 + (ob ^ (((ob >> 9) & 1) << 5)); }
__host__ __device__ __forceinline__ void stage_rc(int b, int& R, int& C) { const int st = b / 1024, sb = b % 1024, swz = sb ^ (((sb >> 9) & 1) << 5); R = (st >> 1) * 16 + swz / 64; C = (st & 1) * 32 + (swz % 64) / 2; }
__host__ __device__ __forceinline__ int perm32(int rho) { const int n = rho >> 4, i = rho & 15; return 8 * (i >> 2) + 4 * n + (i & 3); }

struct Unit { int pm, pn; };
struct Gemm { const bf16_t* A; const bf16_t* Bt; int M, N, K, lda, ldb; };

struct StaticOrder {
    int nM, nN, nwg, G, c;
    __host__ __device__ void init(int M, int N, int G_, int c_) { nM = M / BM; nN = N / BM; nwg = nM * nN; G = G_; c = c_; }
    __host__ __device__ bool next(int i, Unit& u) const {
        const long L = (long)i * G + c; if (L >= nwg) return false;
        int wgid = (int)L; { const int q = nwg / NXCD, r = nwg % NXCD, xcd = wgid % NXCD, off = wgid / NXCD; wgid = (xcd < r ? xcd * (q + 1) : r * (q + 1) + (xcd - r) * q) + off; }
        const int nig = WGM * nN, gid = wgid / nig, fm = gid * WGM, gsz = (nM - fm) < WGM ? (nM - fm) : WGM;
        u.pm = fm + ((wgid % nig) % gsz); u.pn = (wgid % nig) / gsz; return true;
    }
    __device__ __forceinline__ void a_ready(const Unit&) const {}
    __device__ __forceinline__ void done(const Unit&) const {}
};

__device__ __forceinline__ unsigned cvt_pk_bf16(float lo, float hi) { unsigned r; asm volatile("v_cvt_pk_bf16_f32 %0, %1, %2" : "=v"(r) : "v"(lo), "v"(hi)); return r; }

template <class Epi, class Sched, bool ALIGN_EPI>
__device__ __forceinline__ void gemm_phase(PG8_LAS unsigned char* lds, const Gemm g, const Sched& S, const Epi& E) {
    const int tid = threadIdx.x, wid = __builtin_amdgcn_readfirstlane(tid >> 6), lane = tid & 63, wr = wid >> 2, wc = wid & 3, fr = lane & 15, fq = lane >> 4;
    const int K = g.K, nt = K / BK;
    unsigned voffA[2], voffB[2];
#pragma unroll
    for (int i = 0; i < 2; ++i) { int R, C; stage_rc(tid * 16 + i * 8192, R, C); const int Rb = (R & ~31) + perm32(R & 31);
        voffA[i] = (unsigned)(R * g.lda + C) * 2u; voffB[i] = (unsigned)(Rb * g.ldb + C) * 2u; }
    const size_t kstep = (size_t)(BK * 2);
    const size_t hstepA = (size_t)HALF * g.lda * 2, hstepB = (size_t)HALF * g.ldb * 2;
    const size_t tstepA = 2 * hstepA, tstepB = 2 * hstepB;
    const unsigned ldsw = (unsigned)wid * 1024u;
    const int aoff = lds_byte(wr * 64 + fr, fq * 8), boff = lds_byte(wc * 32 + fr, fq * 8);
#define PG8_SA(b, h) (((b) * 2 + (h)) * HTB)
#define PG8_SB(b, h) ((4 + (b) * 2 + (h)) * HTB)
#define PG8_STAGE(bufoff, gbase, voff) do { _Pragma("unroll") for (int _i = 0; _i < 2; ++_i) \
        __builtin_amdgcn_global_load_lds((const unsigned*)((const char*)(gbase) + (voff)[_i]), (PG8_LAS unsigned*)(lds + (bufoff) + ldsw + _i * 8192), 16, 0, 0); } while (0)
#define PG8_LDA(dst, b, h) do { _Pragma("unroll") for (int m = 0; m < 4; ++m) _Pragma("unroll") for (int k = 0; k < 2; ++k) dst[m][k] = *(const PG8_LAS bf16x8*)(lds + PG8_SA(b, h) + aoff + m * 2048 + k * 1024); } while (0)
#define PG8_LDB(dst, b, h) do { _Pragma("unroll") for (int n = 0; n < 2; ++n) _Pragma("unroll") for (int k = 0; k < 2; ++k) dst[n][k] = *(const PG8_LAS bf16x8*)(lds + PG8_SB(b, h) + boff + n * 2048 + k * 1024); } while (0)
#define PG8_MMA(ai, bj, At, Bt) do { __builtin_amdgcn_s_setprio(1); _Pragma("unroll") for (int m = 0; m < 4; ++m) _Pragma("unroll") for (int n = 0; n < 2; ++n) _Pragma("unroll") for (int k = 0; k < 2; ++k) \
        acc[ai][bj][m][n] = __builtin_amdgcn_mfma_f32_16x16x32_bf16(Bt[n][k], At[m][k], acc[ai][bj][m][n], 0, 0, 0); __builtin_amdgcn_s_setprio(0); } while (0)
#define PG8_WAIT_V(n) asm volatile("s_waitcnt vmcnt(" #n ")" ::: "memory")
#define PG8_WAIT_L(n) asm volatile("s_waitcnt lgkmcnt(" #n ")" ::: "memory")
#define PG8_BAR __builtin_amdgcn_s_barrier()
#define PG8_SCHED __builtin_amdgcn_sched_barrier(0)
    Unit cur, nxt; int ui = 0;
    if (!S.next(0, cur)) return;
    f32x4 acc[2][2][4][2];
#pragma unroll
    for (int a = 0; a < 2; ++a)
#pragma unroll
        for (int b = 0; b < 2; ++b)
#pragma unroll
            for (int m = 0; m < 4; ++m)
#pragma unroll
                for (int n = 0; n < 2; ++n) acc[a][b][m][n] = (f32x4){0.f, 0.f, 0.f, 0.f};
    bf16x8 At[4][2], B0[2][2], B1[2][2];
    const char* cA = (const char*)g.A + (size_t)cur.pm * tstepA; const char* cB = (const char*)g.Bt + (size_t)cur.pn * tstepB;
    S.a_ready(cur);
    PG8_STAGE(PG8_SB(0, 0), cB, voffB); PG8_STAGE(PG8_SB(0, 1), cB + hstepB, voffB); PG8_STAGE(PG8_SA(0, 0), cA, voffA); PG8_STAGE(PG8_SA(0, 1), cA + hstepA, voffA);
    if (wr == 1) PG8_BAR;
    PG8_WAIT_V(2); PG8_BAR;
    PG8_STAGE(PG8_SB(1, 0), cB + kstep, voffB); PG8_STAGE(PG8_SA(1, 0), cA + kstep, voffA); PG8_STAGE(PG8_SB(1, 1), cB + hstepB + kstep, voffB);
    PG8_WAIT_V(6); PG8_BAR;
    for (;;) {
        const bool has_next = S.next(ui + 1, nxt);
        const char* nA = has_next ? (const char*)g.A + (size_t)nxt.pm * tstepA : cA; const char* nB = has_next ? (const char*)g.Bt + (size_t)nxt.pn * tstepB : cB;
        for (int t = 0; t < nt; t += 2) {
            const bool last = (t == nt - 2);
            const char* a1 = cA + (size_t)(t + 1) * kstep;
            const char* a2 = last ? nA : cA + (size_t)(t + 2) * kstep; const char* b2 = last ? nB : cB + (size_t)(t + 2) * kstep;
            const char* a3 = a2 + kstep; const char* b3 = b2 + kstep;
            if (last && has_next) S.a_ready(nxt);
            PG8_LDB(B0, 0, 0); PG8_LDB(B1, 0, 1); PG8_SCHED; PG8_LDA(At, 0, 0); PG8_STAGE(PG8_SA(1, 1), a1 + hstepA, voffA);
            PG8_WAIT_V(8); PG8_WAIT_L(0); PG8_BAR; PG8_MMA(0, 0, At, B0); PG8_MMA(0, 1, At, B1); PG8_BAR; PG8_SCHED;
            PG8_LDA(At, 0, 1); PG8_STAGE(PG8_SB(0, 0), b2, voffB); PG8_STAGE(PG8_SB(0, 1), b2 + hstepB, voffB); PG8_STAGE(PG8_SA(0, 0), a2, voffA);
            PG8_WAIT_V(8); PG8_WAIT_L(0); PG8_BAR; PG8_MMA(1, 0, At, B0); PG8_MMA(1, 1, At, B1); PG8_BAR; PG8_SCHED;
            PG8_LDB(B0, 1, 0); PG8_LDB(B1, 1, 1); PG8_SCHED; PG8_LDA(At, 1, 0); PG8_STAGE(PG8_SA(0, 1), a2 + hstepA, voffA);
            PG8_WAIT_V(8); PG8_WAIT_L(0); PG8_BAR; PG8_MMA(0, 0, At, B0); PG8_MMA(0, 1, At, B1); PG8_BAR; PG8_SCHED;
            PG8_LDA(At, 1, 1); PG8_STAGE(PG8_SB(1, 0), b3, voffB); PG8_STAGE(PG8_SB(1, 1), b3 + hstepB, voffB); PG8_STAGE(PG8_SA(1, 0), a3, voffA);
            PG8_WAIT_V(8); PG8_WAIT_L(0); PG8_BAR; PG8_MMA(1, 0, At, B0); PG8_MMA(1, 1, At, B1); PG8_BAR; PG8_SCHED;
        }
        if constexpr (ALIGN_EPI) { if (wr == 0) PG8_BAR; }
        E(acc, cur, wr, wc, fr, fq); S.done(cur);
        if (!has_next) break;
#pragma unroll
        for (int a = 0; a < 2; ++a)
#pragma unroll
            for (int b = 0; b < 2; ++b)
#pragma unroll
                for (int m = 0; m < 4; ++m)
#pragma unroll
                    for (int n = 0; n < 2; ++n) acc[a][b][m][n] = (f32x4){0.f, 0.f, 0.f, 0.f};
        cur = nxt; cA = nA; cB = nB; ++ui;
        if constexpr (ALIGN_EPI) { if (wr == 1) PG8_BAR; }
    }
    PG8_WAIT_V(0);
    if constexpr (!ALIGN_EPI) { if (wr == 0) PG8_BAR; }
    PG8_BAR;
#undef PG8_SA
#undef PG8_SB
#undef PG8_STAGE
#undef PG8_LDA
#undef PG8_LDB
#undef PG8_MMA
#undef PG8_WAIT_V
#undef PG8_WAIT_L
#undef PG8_BAR
#undef PG8_SCHED
}
}

constexpr int NWAVES = 8, NTHREADS = NWAVES * 64;
constexpr int N_LAUNCHES = MK_N_LAUNCHES;
constexpr int N_PHASES = 11;
constexpr int DM = 1024, SEQ = 2048, NSEQ_P = 8, NSEQ = 24, T_P = NSEQ_P * SEQ, TT = NSEQ * SEQ;
constexpr int RW = 512, NHEAD = 4, DH = 128, INW = 2560, DFF = 2816, NUP = 2 * DFF;
constexpr int SG = 32, SCH = 16, SNS = 64;
constexpr float EPS = 1e-6f;

typedef unsigned short bf16;
typedef float f32x4 __attribute__((ext_vector_type(4)));
typedef unsigned v4u __attribute__((ext_vector_type(4)));
typedef unsigned v2u __attribute__((ext_vector_type(2)));
#define GAS __attribute__((address_space(1)))
#define LAS __attribute__((address_space(3)))
typedef GAS unsigned gu32;
#define RLX_AGENT __ATOMIC_RELAXED, __HIP_MEMORY_SCOPE_AGENT
#define LDS_WAIT() asm volatile("s_waitcnt lgkmcnt(0)" ::: "memory")

constexpr size_t MiB = 1u << 20;
constexpr size_t WS_CTL = 0, CTL_ZERO_BYTES = 64 * 1024;
constexpr size_t WS_ROT = 1 * MiB;
constexpr size_t WS_SS1 = 2 * MiB;
constexpr size_t WS_WIN = 4 * MiB, WS_WGLU = 9 * MiB, WS_WOUT = 10 * MiB, WS_WUP = 12 * MiB, WS_WDN = 23 * MiB;
constexpr size_t WS_H1 = 48 * MiB;
constexpr size_t WS_MIX = 48 * MiB;
constexpr size_t WS_Q = 144 * MiB, WS_K = 192 * MiB, WS_V = 240 * MiB, WS_G = 288 * MiB;
constexpr size_t WS_UX = 336 * MiB;
constexpr size_t WS_YB = 432 * MiB;
constexpr size_t WS_ACT = 48 * MiB;
constexpr size_t WS_X2B = 312 * MiB;
constexpr size_t WS_ZB = 408 * MiB;
constexpr size_t WS_END = 480 * MiB;
static_assert(WS_ACT + (size_t)TT * DFF * 2 <= WS_X2B && WS_X2B + (size_t)TT * DM * 2 <= WS_ZB && WS_ZB + (size_t)768 * 4 * NUP * 2 <= WS_END, "ws map");
constexpr int CW_BAR = 1024;

constexpr int RING_BYTES = 131072;
constexpr int LDSCTL_OFF = RING_BYTES, MISC_OFF = LDSCTL_OFF + 320;
constexpr int LDS_BYTES = 147456;

__device__ __forceinline__ unsigned f2bf(float f) { unsigned u = __builtin_bit_cast(unsigned, f); return (u + 0x7fffu + ((u >> 16) & 1u)) >> 16; }
__device__ __forceinline__ unsigned pk2(float lo, float hi) { return f2bf(lo) | (f2bf(hi) << 16); }
__device__ __forceinline__ float bf_lo(unsigned w) { return __builtin_bit_cast(float, w << 16); }
__device__ __forceinline__ float bf_hi(unsigned w) { return __builtin_bit_cast(float, w & 0xffff0000u); }
__device__ __forceinline__ float gelu_tanh(float x) {
    const float t = x * (1.0f + 0.044715f * x * x) * (-2.0f * 0.7978845608028654f * 1.4426950408889634f);
    return x * __builtin_amdgcn_rcpf(1.0f + __builtin_amdgcn_exp2f(t));
}
__device__ __forceinline__ float sigmoidf_(float x) { return __builtin_amdgcn_rcpf(1.0f + __builtin_amdgcn_exp2f(-1.4426950408889634f * x)); }
__device__ __forceinline__ float wave_sum(float v) {
#pragma unroll
    for (int o = 1; o < 64; o <<= 1) v += __shfl_xor(v, o);
    return v;
}

#define XB_TMO      128
#define XB_XCNT(j)  (256  + 64 * (j))
#define XB_XSUB(j)  (1280 + 64 * (j))
#define XB_XGEN(j)  (2304 + 64 * (j))
#define XB_TOP      3328
#define XB_TOPGEN   3392
#define XCD_BAR_WORDS 3456
#define XB_SPIN_CAP (1u << 24)
__device__ __forceinline__ unsigned xb_ld(unsigned* p)              { return __hip_atomic_load(p, __ATOMIC_RELAXED, __HIP_MEMORY_SCOPE_AGENT); }
__device__ __forceinline__ unsigned xb_add(unsigned* p, unsigned v) { return __hip_atomic_fetch_add(p, v, __ATOMIC_RELAXED, __HIP_MEMORY_SCOPE_AGENT); }
__device__ __forceinline__ unsigned xb_xcc_id() { return (unsigned)__builtin_amdgcn_s_getreg((3 << 11) | 20) & 0xFu; }
#define XB_SPIN(cond, bar) do { unsigned _sp = 0; while (cond) { __builtin_amdgcn_s_sleep(1); \
    if ((++_sp & 255u) == 0u) { if (xb_ld(&(bar)[XB_TMO])) break; if (_sp > XB_SPIN_CAP) { atomicAdd(&(bar)[XB_TMO], 1u); break; } } } } while (0)
struct XcdBarrier { unsigned* bar; unsigned x; volatile LAS unsigned* st; };
__device__ __forceinline__ XcdBarrier xcd_barrier_post(unsigned* bar, volatile LAS unsigned* st) {
    XcdBarrier b; b.bar = bar; b.x = xb_xcc_id(); b.st = st;
    if (threadIdx.x == 0) (void)xb_add(&bar[XB_XCNT(b.x)], 1u);
    return b;
}
__device__ __forceinline__ void xcd_barrier_complete(unsigned* bar, unsigned x, unsigned& nloc, unsigned& nx) {
    const unsigned G = gridDim.x * gridDim.y * gridDim.z;
    unsigned sum, cnt, mine, sp = 0u;
    for (;;) {
        sum = 0u; cnt = 0u; mine = 0u;
#pragma unroll
        for (unsigned j = 0; j < 16; ++j) { const unsigned c = xb_ld(&bar[XB_XCNT(j)]); sum += c; cnt += (c > 0u) ? 1u : 0u; mine = (j == x) ? c : mine; }
        if (sum == G) break;
        __builtin_amdgcn_s_sleep(1);
        if ((++sp & 255u) == 0u) { if (xb_ld(&bar[XB_TMO])) break; if (sp > XB_SPIN_CAP) { atomicAdd(&bar[XB_TMO], 1u); break; } }
    }
    nloc = mine > 0u ? mine : 1u; nx = cnt > 0u ? cnt : 1u;
}
__device__ __forceinline__ void xcd_barrier(const XcdBarrier& b) {
    asm volatile("s_waitcnt vmcnt(0)" ::: "memory");
    __syncthreads();
    if (threadIdx.x == 0) {
        unsigned* bar = b.bar;
        __builtin_amdgcn_s_waitcnt(0);
        unsigned nloc = b.st[0], nx = b.st[1];
        if (nloc == 0u) { xcd_barrier_complete(bar, b.x, nloc, nx); b.st[0] = nloc; b.st[1] = nx; }
        const unsigned old = xb_add(&bar[XB_XSUB(b.x)], 1u);
        const unsigned gen = old / nloc;
        if (old + 1u == (gen + 1u) * nloc) {
            __builtin_amdgcn_fence(__ATOMIC_RELEASE, "agent");
            asm volatile("s_waitcnt vmcnt(0)" ::: "memory");
            const unsigned og = xb_add(&bar[XB_TOP], 1u);
            const unsigned tg = og / nx;
            if (og + 1u == (tg + 1u) * nx) xb_add(&bar[XB_TOPGEN], 1u);
            else XB_SPIN(xb_ld(&bar[XB_TOPGEN]) == tg, bar);
            __builtin_amdgcn_fence(__ATOMIC_ACQUIRE, "agent");
            xb_add(&bar[XB_XGEN(b.x)], 1u);
            asm volatile("s_waitcnt vmcnt(0)" ::: "memory");
        } else {
            XB_SPIN(xb_ld(&bar[XB_XGEN(b.x)]) == gen, bar);
            __builtin_amdgcn_fence(__ATOMIC_ACQUIRE, "agent");
            asm volatile("s_waitcnt vmcnt(0)" ::: "memory");
        }
    }
    __syncthreads();
}

struct Args { const float* in[22]; float* out; unsigned char* ws; int ph_lo, ph_hi; };
enum { I_XP = 0, I_XS, I_NMIX, I_WIN, I_GN, I_LRE, I_LIM, I_LDT, I_BRE, I_BIM, I_CRE, I_CIM, I_SD, I_GLUW, I_GLUB, I_WOUT, I_NFFN, I_WUP, I_CONVW, I_CONVB, I_WDN, I_NFIN };

template <int MODE>
__device__ __forceinline__ int w_dst_row(int n) {
    if (MODE == 1) {
        if (n >= 2 * RW) return n;
        const int sec = n >> 9, hh = (n >> 7) & 3, d = n & 127, nb = d >> 6, j = d & 63;
        const int p = 32 * (j >> 4) + 8 * ((j >> 2) & 3) + 4 * nb + (j & 3);
        return sec * RW + hh * DH + p;
    } else if (MODE == 2) {
        const int gate = n >= DFF ? 1 : 0, c = n - gate * DFF;
        return (c >> 7) * 256 + gate * 128 + (c & 127);
    }
    return n;
}
template <int MODE>
__device__ __forceinline__ void p0_transpose_item(const float* W, int K, int N, bf16* WT, const float* kgain, LAS float* scr, int item, int lane) {
    const int nblk = N / 32, kb = item / nblk, nb = item % nblk, k0 = 64 * kb, n0 = 32 * nb;
#pragma unroll 8
    for (int i = 0; i < 32; ++i) { const int kk = 2 * i + (lane >> 5); float w = W[(size_t)(k0 + kk) * N + n0 + (lane & 31)]; if (MODE == 2) w *= kgain[k0 + kk]; scr[kk * 33 + (lane & 31)] = w; }
    LDS_WAIT(); asm volatile("" ::: "memory");
    const int c = lane & 7;
#pragma unroll
    for (int j = 0; j < 4; ++j) { const int n = (lane >> 3) + 8 * j; const LAS float* s = scr + (8 * c) * 33 + n;
        const int ng = n0 + n; float sc = 1.0f; if (MODE == 1) { if (ng >= RW && ng < 2 * RW) sc = 0.08838834764831845f; }
        v4u o; o.x = pk2(s[0 * 33] * sc, s[1 * 33] * sc); o.y = pk2(s[2 * 33] * sc, s[3 * 33] * sc); o.z = pk2(s[4 * 33] * sc, s[5 * 33] * sc); o.w = pk2(s[6 * 33] * sc, s[7 * 33] * sc);
        *(GAS v4u*)(WT + (size_t)w_dst_row<MODE>(ng) * K + k0 + 8 * c) = o; }
    LDS_WAIT(); asm volatile("" ::: "memory");
}
__device__ __forceinline__ const float* x_row(const Args& a, int m) { return m < T_P ? a.in[I_XP] + (size_t)m * DM : a.in[I_XS] + (size_t)(m - T_P) * DM; }

__device__ __forceinline__ void p0_prologue(const Args& a, LAS unsigned char* lds, int wave, int lane, int vcu, int G) {
    unsigned char* ws = a.ws;
    LAS float* scr = (LAS float*)(lds + wave * 16384);
    const int gw = vcu * NWAVES + wave, NGW = G * NWAVES;
    constexpr int I_IN = (DM / 64) * (INW / 32), I_GLU = (RW / 64) * (RW / 32), I_OUT = (DM / 64) * (DM / 32), I_UP = (DM / 64) * (NUP / 32), I_DN = (DFF / 64) * (DM / 32);
    constexpr int NITEMS = I_IN + I_GLU + I_OUT + I_UP + I_DN;
    for (int it = gw; it < NITEMS; it += NGW) {
        int r = it;
        if (r < I_IN) { p0_transpose_item<1>(a.in[I_WIN], DM, INW, (bf16*)(ws + WS_WIN), nullptr, scr, r, lane); continue; } r -= I_IN;
        if (r < I_GLU) { p0_transpose_item<0>(a.in[I_GLUW], RW, RW, (bf16*)(ws + WS_WGLU), nullptr, scr, r, lane); continue; } r -= I_GLU;
        if (r < I_OUT) { p0_transpose_item<0>(a.in[I_WOUT], DM, DM, (bf16*)(ws + WS_WOUT), nullptr, scr, r, lane); continue; } r -= I_OUT;
        if (r < I_UP) { p0_transpose_item<2>(a.in[I_WUP], DM, NUP, (bf16*)(ws + WS_WUP), a.in[I_NFFN], scr, r, lane); continue; } r -= I_UP;
        p0_transpose_item<0>(a.in[I_WDN], DFF, DM, (bf16*)(ws + WS_WDN), nullptr, scr, r, lane);
    }
    {
        const GAS f32x4* gn = (const GAS f32x4*)a.in[I_NMIX] + lane;
        f32x4 gv[4];
#pragma unroll
        for (int j = 0; j < 4; ++j) gv[j] = gn[64 * j];
        for (int m = gw; m < TT; m += NGW) {
            const GAS f32x4* xr = (const GAS f32x4*)x_row(a, m) + lane;
            f32x4 v[4]; float s = 0.f;
#pragma unroll
            for (int j = 0; j < 4; ++j) { v[j] = xr[64 * j]; s += (v[j].x * v[j].x + v[j].y * v[j].y) + (v[j].z * v[j].z + v[j].w * v[j].w); }
            const float rinv = 1.0f / sqrtf(wave_sum(s) * (1.0f / DM) + EPS);
            GAS unsigned long long* o8 = (GAS unsigned long long*)((bf16*)(ws + WS_H1) + (size_t)m * DM) + lane;
#pragma unroll
            for (int j = 0; j < 4; ++j) o8[64 * j] = (unsigned long long)pk2(v[j].x * rinv * gv[j].x, v[j].y * rinv * gv[j].y) | ((unsigned long long)pk2(v[j].z * rinv * gv[j].z, v[j].w * rinv * gv[j].w) << 32);
        }
    }
    {
        const int gt = gw * 64 + lane, NGT = NGW * 64;
        float* rc = (float*)(ws + WS_ROT); float* rs = rc + SEQ * 64;
        for (int i = gt; i < SEQ * 64; i += NGT) {
            const int pos = i >> 6, f = i & 63;
            const float inv = (float)pow(10000.0, -(double)f / 64.0);
            const float ang = (float)pos * inv;
            rc[i] = (float)cos((double)ang); rs[i] = (float)sin((double)ang);
        }
        float* ss1 = (float*)(ws + WS_SS1);
        for (int i = gt; i < TT; i += NGT) ss1[i] = 0.f;
    }
}

using pg8::Unit; using pg8::cvt_pk_bf16;
struct EpiIn {
    bf16 *Q, *Kk, *V, *Gt, *UX; const float* rotc; const float* rots;
    __device__ __forceinline__ void operator()(const f32x4 (&acc)[2][2][4][2], const Unit& u, int wr, int wc, int fr, int fq) const {
        const int sec = u.pn >> 1, half = u.pn & 1;
        const int row0 = u.pm * 256 + wr * 64 + fr;
        if (sec < 2) {
            bf16* dst = sec == 0 ? Q : Kk;
            const int f0 = 16 * wc + 4 * fq;
#pragma unroll
            for (int ai = 0; ai < 2; ++ai)
#pragma unroll
                for (int m = 0; m < 4; ++m) {
                    const int row = row0 + ai * 128 + m * 16, pos = row & (SEQ - 1);
                    const f32x4 c = *(const f32x4*)(rotc + pos * 64 + f0), s = *(const f32x4*)(rots + pos * 64 + f0);
#pragma unroll
                    for (int bj = 0; bj < 2; ++bj) {
                        const f32x4 x1 = acc[ai][bj][m][0], x2 = acc[ai][bj][m][1];
                        const f32x4 o1 = x1 * c - x2 * s, o2 = x1 * s + x2 * c;
                        v4u w; w.x = cvt_pk_bf16(o1[0], o1[1]); w.y = cvt_pk_bf16(o1[2], o1[3]); w.z = cvt_pk_bf16(o2[0], o2[1]); w.w = cvt_pk_bf16(o2[2], o2[3]);
                        *(v4u*)(dst + (size_t)row * RW + (half * 2 + bj) * DH + 32 * wc + 8 * fq) = w;
                    }
                }
        } else if (sec < 4) {
            bf16* dst = sec == 2 ? V : Gt;
#pragma unroll
            for (int ai = 0; ai < 2; ++ai)
#pragma unroll
                for (int m = 0; m < 4; ++m) {
                    const int row = row0 + ai * 128 + m * 16;
#pragma unroll
                    for (int bj = 0; bj < 2; ++bj) {
                        const f32x4 v0 = acc[ai][bj][m][0], v1 = acc[ai][bj][m][1];
                        v4u w; w.x = cvt_pk_bf16(v0[0], v0[1]); w.y = cvt_pk_bf16(v0[2], v0[3]); w.z = cvt_pk_bf16(v1[0], v1[1]); w.w = cvt_pk_bf16(v1[2], v1[3]);
                        *(v4u*)(dst + (size_t)row * RW + half * 256 + bj * 128 + 32 * wc + 8 * fq) = w;
                    }
                }
        } else {
#pragma unroll
            for (int ai = 0; ai < 2; ++ai)
#pragma unroll
                for (int m = 0; m < 4; ++m) {
                    const int row = row0 + ai * 128 + m * 16;
#pragma unroll
                    for (int bj = 0; bj < 2; ++bj) {
                        const int cu = half * 256 + bj * 128 + 32 * wc + 8 * fq, g = cu >> 4, ci0 = cu & 15;
                        const f32x4 v0 = acc[ai][bj][m][0], v1 = acc[ai][bj][m][1];
                        v4u w; w.x = cvt_pk_bf16(v0[0], v0[1]); w.y = cvt_pk_bf16(v0[2], v0[3]); w.z = cvt_pk_bf16(v1[0], v1[1]); w.w = cvt_pk_bf16(v1[2], v1[3]);
                        *(v4u*)(UX + ((size_t)g * (TT / 16) + (row >> 4)) * 512 + (row & 15) * 16 + ci0) = w;
                    }
                }
        }
    }
};
struct EpiGlu {
    const bf16* YB; const float* bias; bf16* MIX;
    __device__ __forceinline__ void operator()(const f32x4 (&acc)[2][2][4][2], const Unit& u, int wr, int wc, int fr, int fq) const {
        const int row0 = u.pm * 256 + wr * 64 + fr, col0 = u.pn * 256 + wc * 32 + 8 * fq;
#pragma unroll
        for (int bj = 0; bj < 2; ++bj) {
            const int c = col0 + bj * 128;
            const f32x4 b0 = *(const f32x4*)(bias + c), b1 = *(const f32x4*)(bias + c + 4);
#pragma unroll
            for (int ai = 0; ai < 2; ++ai)
#pragma unroll
                for (int m = 0; m < 4; ++m) {
                    const int row = row0 + ai * 128 + m * 16;
                    const v4u yw = *(const v4u*)(YB + (size_t)row * RW + c);
                    const f32x4 g0 = acc[ai][bj][m][0] + b0, g1 = acc[ai][bj][m][1] + b1;
                    v4u w;
                    w.x = cvt_pk_bf16(bf_lo(yw.x) * sigmoidf_(g0[0]), bf_hi(yw.x) * sigmoidf_(g0[1]));
                    w.y = cvt_pk_bf16(bf_lo(yw.y) * sigmoidf_(g0[2]), bf_hi(yw.y) * sigmoidf_(g0[3]));
                    w.z = cvt_pk_bf16(bf_lo(yw.z) * sigmoidf_(g1[0]), bf_hi(yw.z) * sigmoidf_(g1[1]));
                    w.w = cvt_pk_bf16(bf_lo(yw.w) * sigmoidf_(g1[2]), bf_hi(yw.w) * sigmoidf_(g1[3]));
                    *(v4u*)(MIX + (size_t)row * DM + RW + c) = w;
                }
        }
    }
};
struct EpiOut {
    const float* xp; const float* xs; float* X2; bf16* X2B; float* ss1;
    __device__ __forceinline__ void operator()(const f32x4 (&acc)[2][2][4][2], const Unit& u, int wr, int wc, int fr, int fq) const {
        const int row0 = u.pm * 256 + wr * 64 + fr, col0 = u.pn * 256 + wc * 32 + 8 * fq;
        const float* xb = (u.pm * 256 < T_P) ? xp : xs - (size_t)T_P * DM;
#pragma unroll
        for (int ai = 0; ai < 2; ++ai)
#pragma unroll
            for (int m = 0; m < 4; ++m) {
                const int row = row0 + ai * 128 + m * 16; float s = 0.f;
#pragma unroll
                for (int bj = 0; bj < 2; ++bj) {
                    const size_t off = (size_t)row * DM + col0 + bj * 128;
                    const f32x4 r0 = *(const f32x4*)(xb + off), r1 = *(const f32x4*)(xb + off + 4);
                    const f32x4 v0 = acc[ai][bj][m][0] + r0, v1 = acc[ai][bj][m][1] + r1;
                    *(f32x4*)(X2 + off) = v0; *(f32x4*)(X2 + off + 4) = v1;
                    v4u w; w.x = cvt_pk_bf16(v0[0], v0[1]); w.y = cvt_pk_bf16(v0[2], v0[3]); w.z = cvt_pk_bf16(v1[0], v1[1]); w.w = cvt_pk_bf16(v1[2], v1[3]);
                    *(v4u*)(X2B + off) = w;
                    s += (v0[0] * v0[0] + v0[1] * v0[1]) + (v0[2] * v0[2] + v0[3] * v0[3]) + (v1[0] * v1[0] + v1[1] * v1[1]) + (v1[2] * v1[2] + v1[3] * v1[3]);
                }
                s += __shfl_xor(s, 16); s += __shfl_xor(s, 32);
                if (fq == 0) atomicAdd(ss1 + row, s);
            }
    }
};
__device__ __forceinline__ float dpp_prev(float v) { return __builtin_bit_cast(float, __builtin_amdgcn_update_dpp(0, __builtin_bit_cast(int, v), 0x121, 0xf, 0xf, false)); }
__device__ __forceinline__ float dpp_next(float v) { return __builtin_bit_cast(float, __builtin_amdgcn_update_dpp(0, __builtin_bit_cast(int, v), 0x12F, 0xf, 0xf, false)); }
__device__ __forceinline__ f32x4 dpp_prev4(f32x4 v) { return (f32x4){dpp_prev(v[0]), dpp_prev(v[1]), dpp_prev(v[2]), dpp_prev(v[3])}; }
__device__ __forceinline__ f32x4 dpp_next4(f32x4 v) { return (f32x4){dpp_next(v[0]), dpp_next(v[1]), dpp_next(v[2]), dpp_next(v[3])}; }
struct EpiUp {
    bf16* ACT; bf16* ZB; const float* ss1; const float* cw; const float* cb;
    __device__ __forceinline__ void operator()(const f32x4 (&acc)[2][2][4][2], const Unit& u, int wr, int wc, int fr, int fq) const {
        const int rowb = u.pm * 256 + wr * 64;
        const int ch0 = u.pn * 128 + wc * 32 + fq * 8;
        float rinv[2][4];
#pragma unroll
        for (int ai = 0; ai < 2; ++ai)
#pragma unroll
            for (int m = 0; m < 4; ++m) rinv[ai][m] = 1.0f / sqrtf(ss1[rowb + ai * 128 + m * 16 + fr] * (1.0f / DM) + EPS);
        unsigned pk[2][4][2];
#pragma unroll
        for (int n = 0; n < 2; ++n) {
            const int cch = ch0 + 4 * n;
            const f32x4 w0v = *(const f32x4*)(cw + cch), w1v = *(const f32x4*)(cw + NUP + cch), w2v = *(const f32x4*)(cw + 2 * NUP + cch), bv = *(const f32x4*)(cb + cch);
            const f32x4 w0g = *(const f32x4*)(cw + DFF + cch), w1g = *(const f32x4*)(cw + NUP + DFF + cch), w2g = *(const f32x4*)(cw + 2 * NUP + DFF + cch), bg = *(const f32x4*)(cb + DFF + cch);
#pragma unroll
            for (int ai = 0; ai < 2; ++ai) {
                const int blk = u.pm * 4 + ai * 2 + wr;
#pragma unroll
                for (int m = 0; m < 4; ++m) {
                    const int mp = m > 0 ? m - 1 : 0, mn = m < 3 ? m + 1 : 3;
                    const f32x4 zv = acc[ai][0][m][n] * rinv[ai][m], zg = acc[ai][1][m][n] * rinv[ai][m];
                    const f32x4 zvp = acc[ai][0][mp][n] * rinv[ai][mp], zgp = acc[ai][1][mp][n] * rinv[ai][mp];
                    const f32x4 zvn = acc[ai][0][mn][n] * rinv[ai][mn], zgn = acc[ai][1][mn][n] * rinv[ai][mn];
                    const f32x4 prv = dpp_prev4(fr == 15 ? zvp : zv), nxv = dpp_next4(fr == 0 ? zvn : zv);
                    const f32x4 prg = dpp_prev4(fr == 15 ? zgp : zg), nxg = dpp_next4(fr == 0 ? zgn : zg);
                    const f32x4 cv = w0v * prv + w1v * zv + w2v * nxv + bv;
                    const f32x4 cg = w0g * prg + w1g * zg + w2g * nxg + bg;
                    const float a0 = gelu_tanh(cg[0]) * cv[0], a1 = gelu_tanh(cg[1]) * cv[1], a2 = gelu_tanh(cg[2]) * cv[2], a3 = gelu_tanh(cg[3]) * cv[3];
                    const unsigned p0 = cvt_pk_bf16(a0, a1), p1 = cvt_pk_bf16(a2, a3);
                    if (n == 0) { pk[ai][m][0] = p0; pk[ai][m][1] = p1; }
                    else {
                        const bool edge = (m == 0 && fr == 0) || (m == 3 && fr == 15);
                        if (!edge) { v4u w; w.x = pk[ai][m][0]; w.y = pk[ai][m][1]; w.z = p0; w.w = p1;
                            *(v4u*)(ACT + (size_t)(rowb + ai * 128 + m * 16 + fr) * DFF + ch0) = w; }
                    }
                    if (m == 0 || m == 3) {
                        const int j = (m == 0) ? fr : fr - 12;
                        if ((m == 0 && fr < 2) || (m == 3 && fr >= 14)) {
                            bf16* zrow = ZB + ((size_t)blk * 4 + j) * NUP;
                            v2u a; a.x = cvt_pk_bf16(zv[0], zv[1]); a.y = cvt_pk_bf16(zv[2], zv[3]); *(v2u*)(zrow + cch) = a;
                            v2u b; b.x = cvt_pk_bf16(zg[0], zg[1]); b.y = cvt_pk_bf16(zg[2], zg[3]); *(v2u*)(zrow + DFF + cch) = b;
                        }
                    }
                }
            }
        }
    }
};
struct EpiDown {
    float* X;
    __device__ __forceinline__ void operator()(const f32x4 (&acc)[2][2][4][2], const Unit& u, int wr, int wc, int fr, int fq) const {
        const int row0 = u.pm * 256 + wr * 64 + fr, col0 = u.pn * 256 + wc * 32 + 8 * fq;
#pragma unroll
        for (int ai = 0; ai < 2; ++ai)
#pragma unroll
            for (int m = 0; m < 4; ++m) {
                const int row = row0 + ai * 128 + m * 16;
#pragma unroll
                for (int bj = 0; bj < 2; ++bj) {
                    const size_t off = (size_t)row * DM + col0 + bj * 128;
                    const f32x4 r0 = *(const f32x4*)(X + off), r1 = *(const f32x4*)(X + off + 4);
                    *(f32x4*)(X + off) = acc[ai][bj][m][0] + r0; *(f32x4*)(X + off + 4) = acc[ai][bj][m][1] + r1;
                }
            }
    }
};

__device__ __forceinline__ void ret_naive(const Args& a, LAS unsigned char* lds, int G) {
    constexpr int LD = 132;
    LAS float* Qs = (LAS float*)lds; LAS float* Ks = Qs + 64 * LD; LAS float* Vs = Ks + 64 * LD; LAS float* Ss = Vs + 64 * LD;
    const bf16* Q = (const bf16*)(a.ws + WS_Q); const bf16* K = (const bf16*)(a.ws + WS_K); const bf16* V = (const bf16*)(a.ws + WS_V); const bf16* Gt = (const bf16*)(a.ws + WS_G);
    bf16* MIX = (bf16*)(a.ws + WS_MIX);
    const int tid = threadIdx.x, lr = tid >> 3, lc = (tid & 7) * 16;
    for (int unit = blockIdx.x; unit < NSEQ * NHEAD * 32; unit += G) {
        const int b = unit >> 7, h = (unit >> 5) & 3, qt = unit & 31;
        const size_t rowbase = (size_t)b * SEQ;
        const float lg2 = log2f(1.0f - exp2f(-5.0f - (float)h));
        __syncthreads();
        { const v4u* src = (const v4u*)(Q + (rowbase + qt * 64 + lr) * RW + h * DH + lc); const v4u w0 = src[0], w1 = src[1]; LAS float* d = Qs + lr * LD + lc;
          d[0] = bf_lo(w0.x); d[1] = bf_hi(w0.x); d[2] = bf_lo(w0.y); d[3] = bf_hi(w0.y); d[4] = bf_lo(w0.z); d[5] = bf_hi(w0.z); d[6] = bf_lo(w0.w); d[7] = bf_hi(w0.w);
          d[8] = bf_lo(w1.x); d[9] = bf_hi(w1.x); d[10] = bf_lo(w1.y); d[11] = bf_hi(w1.y); d[12] = bf_lo(w1.z); d[13] = bf_hi(w1.z); d[14] = bf_lo(w1.w); d[15] = bf_hi(w1.w); }
        float o[16];
#pragma unroll
        for (int j = 0; j < 16; ++j) o[j] = 0.f;
        for (int kt = 0; kt < 32; ++kt) {
            __syncthreads();
            { const v4u* src = (const v4u*)(K + (rowbase + kt * 64 + lr) * RW + h * DH + lc); const v4u w0 = src[0], w1 = src[1]; LAS float* d = Ks + lr * LD + lc;
              d[0] = bf_lo(w0.x); d[1] = bf_hi(w0.x); d[2] = bf_lo(w0.y); d[3] = bf_hi(w0.y); d[4] = bf_lo(w0.z); d[5] = bf_hi(w0.z); d[6] = bf_lo(w0.w); d[7] = bf_hi(w0.w);
              d[8] = bf_lo(w1.x); d[9] = bf_hi(w1.x); d[10] = bf_lo(w1.y); d[11] = bf_hi(w1.y); d[12] = bf_lo(w1.z); d[13] = bf_hi(w1.z); d[14] = bf_lo(w1.w); d[15] = bf_hi(w1.w); }
            { const v4u* src = (const v4u*)(V + (rowbase + kt * 64 + lr) * RW + h * DH + lc); const v4u w0 = src[0], w1 = src[1]; LAS float* d = Vs + lr * LD + lc;
              d[0] = bf_lo(w0.x); d[1] = bf_hi(w0.x); d[2] = bf_lo(w0.y); d[3] = bf_hi(w0.y); d[4] = bf_lo(w0.z); d[5] = bf_hi(w0.z); d[6] = bf_lo(w0.w); d[7] = bf_hi(w0.w);
              d[8] = bf_lo(w1.x); d[9] = bf_hi(w1.x); d[10] = bf_lo(w1.y); d[11] = bf_hi(w1.y); d[12] = bf_lo(w1.z); d[13] = bf_hi(w1.z); d[14] = bf_lo(w1.w); d[15] = bf_hi(w1.w); }
            __syncthreads();
            {
                float s[8];
#pragma unroll
                for (int jj = 0; jj < 8; ++jj) s[jj] = 0.f;
                for (int d4 = 0; d4 < 32; ++d4) {
                    const f32x4 qv = *(const LAS f32x4*)(Qs + lr * LD + d4 * 4);
#pragma unroll
                    for (int jj = 0; jj < 8; ++jj) { const f32x4 kv = *(const LAS f32x4*)(Ks + ((tid & 7) + 8 * jj) * LD + d4 * 4); s[jj] += (qv[0] * kv[0] + qv[1] * kv[1]) + (qv[2] * kv[2] + qv[3] * kv[3]); }
                }
#pragma unroll
                for (int jj = 0; jj < 8; ++jj) { const int m = (tid & 7) + 8 * jj; const int dist = abs((qt * 64 + lr) - (kt * 64 + m)); Ss[lr * 65 + m] = s[jj] * exp2f(lg2 * (float)dist); }
            }
            __syncthreads();
            for (int m = 0; m < 64; ++m) {
                const float sv = Ss[lr * 65 + m];
#pragma unroll
                for (int j4 = 0; j4 < 4; ++j4) { const f32x4 vv = *(const LAS f32x4*)(Vs + m * LD + lc + j4 * 4); o[j4 * 4 + 0] += sv * vv[0]; o[j4 * 4 + 1] += sv * vv[1]; o[j4 * 4 + 2] += sv * vv[2]; o[j4 * 4 + 3] += sv * vv[3]; }
            }
        }
        float ss = 0.f;
#pragma unroll
        for (int j = 0; j < 16; ++j) ss += o[j] * o[j];
        ss += __shfl_xor(ss, 1); ss += __shfl_xor(ss, 2); ss += __shfl_xor(ss, 4);
        const float rn = 1.0f / sqrtf(ss * (1.0f / DH) + EPS);
        const size_t row = rowbase + qt * 64 + lr;
        const v4u* gsrc = (const v4u*)(Gt + row * RW + h * DH + lc); const v4u g0 = gsrc[0], g1 = gsrc[1];
        const float gg[16] = {bf_lo(g0.x), bf_hi(g0.x), bf_lo(g0.y), bf_hi(g0.y), bf_lo(g0.z), bf_hi(g0.z), bf_lo(g0.w), bf_hi(g0.w), bf_lo(g1.x), bf_hi(g1.x), bf_lo(g1.y), bf_hi(g1.y), bf_lo(g1.z), bf_hi(g1.z), bf_lo(g1.w), bf_hi(g1.w)};
        const float* gain = a.in[I_GN] + h * DH + lc;
        unsigned w[8];
#pragma unroll
        for (int j = 0; j < 8; ++j) { const float r0 = gg[2 * j] * sigmoidf_(gg[2 * j]) * gain[2 * j] * o[2 * j] * rn, r1 = gg[2 * j + 1] * sigmoidf_(gg[2 * j + 1]) * gain[2 * j + 1] * o[2 * j + 1] * rn; w[j] = pk2(r0, r1); }
        v4u* dst = (v4u*)(MIX + row * DM + h * DH + lc);
        dst[0] = (v4u){w[0], w[1], w[2], w[3]}; dst[1] = (v4u){w[4], w[5], w[6], w[7]};
    }
}
__device__ __forceinline__ void s5_naive(const Args& a, int wave, int lane, int G) {
    const bf16* UX = (const bf16*)(a.ws + WS_UX);
    float* YF = a.out;
    for (int task = blockIdx.x * NWAVES + wave; task < NSEQ * SG * 2; task += G * NWAVES) {
        const int dir = task & 1, g = (task >> 1) & 31, b = task >> 6;
        const int pidx = (dir * SG + g) * SNS + lane;
        const float lr = fminf(a.in[I_LRE][pidx], -1e-4f), li = a.in[I_LIM][pidx], dt = expf(a.in[I_LDT][dir * SG + g]);
        const float mag = expf(lr * dt); const float ar = mag * cosf(li * dt), ai = mag * sinf(li * dt);
        const float den = lr * lr + li * li, nr = ar - 1.0f, ni = ai;
        const float cr = (nr * lr + ni * li) / den, ci = (ni * lr - nr * li) / den;
        float bbr[16], bbi[16], cre[16], cim[16];
#pragma unroll
        for (int c = 0; c < 16; ++c) { const float br = a.in[I_BRE][(size_t)pidx * 16 + c], bi = a.in[I_BIM][(size_t)pidx * 16 + c]; bbr[c] = cr * br - ci * bi; bbi[c] = cr * bi + ci * br;
            cre[c] = a.in[I_CRE][((size_t)(dir * SG + g) * 16 + c) * SNS + lane]; cim[c] = a.in[I_CIM][((size_t)(dir * SG + g) * 16 + c) * SNS + lane]; }
        float xr = 0.f, xi = 0.f;
        const int cosel = ((lane >> 5) & 1) * 8 + ((lane >> 4) & 1) * 4 + ((lane >> 3) & 1) * 2 + ((lane >> 2) & 1);
        for (int step0 = 0; step0 < SEQ; step0 += 8) {
            v4u ub[8][2];
#pragma unroll
            for (int s8 = 0; s8 < 8; ++s8) {
                const int t = dir ? (SEQ - 1 - (step0 + s8)) : (step0 + s8); const size_t row = (size_t)b * SEQ + t;
                const v4u* up = (const v4u*)(UX + ((size_t)g * (TT / 16) + (row >> 4)) * 512 + (row & 15) * 16);
                ub[s8][0] = up[0]; ub[s8][1] = up[1];
            }
#pragma unroll
            for (int s8 = 0; s8 < 8; ++s8) {
            const int t = dir ? (SEQ - 1 - (step0 + s8)) : (step0 + s8); const size_t row = (size_t)b * SEQ + t;
            const v4u u0 = ub[s8][0], u1 = ub[s8][1];
            const float uu[16] = {bf_lo(u0.x), bf_hi(u0.x), bf_lo(u0.y), bf_hi(u0.y), bf_lo(u0.z), bf_hi(u0.z), bf_lo(u0.w), bf_hi(u0.w), bf_lo(u1.x), bf_hi(u1.x), bf_lo(u1.y), bf_hi(u1.y), bf_lo(u1.z), bf_hi(u1.z), bf_lo(u1.w), bf_hi(u1.w)};
            float bur = 0.f, bui = 0.f;
#pragma unroll
            for (int c = 0; c < 16; ++c) { bur += bbr[c] * uu[c]; bui += bbi[c] * uu[c]; }
            const float nxr = ar * xr - ai * xi + bur, nxi = ar * xi + ai * xr + bui; xr = nxr; xi = nxi;
            float p[16];
#pragma unroll
            for (int c = 0; c < 16; ++c) p[c] = cre[c] * xr - cim[c] * xi;
#pragma unroll
            for (int i = 0; i < 8; ++i) { const bool up_ = (lane & 32) != 0; const float send = up_ ? p[i] : p[i + 8], keep = up_ ? p[i + 8] : p[i]; p[i] = keep + __shfl_xor(send, 32); }
#pragma unroll
            for (int i = 0; i < 4; ++i) { const bool up_ = (lane & 16) != 0; const float send = up_ ? p[i] : p[i + 4], keep = up_ ? p[i + 4] : p[i]; p[i] = keep + __shfl_xor(send, 16); }
#pragma unroll
            for (int i = 0; i < 2; ++i) { const bool up_ = (lane & 8) != 0; const float send = up_ ? p[i] : p[i + 2], keep = up_ ? p[i + 2] : p[i]; p[i] = keep + __shfl_xor(send, 8); }
            { const bool up_ = (lane & 4) != 0; const float send = up_ ? p[0] : p[1], keep = up_ ? p[1] : p[0]; p[0] = keep + __shfl_xor(send, 4); }
            p[0] += __shfl_xor(p[0], 2); p[0] += __shfl_xor(p[0], 1);
            if ((lane & 3) == 0) YF[((size_t)dir * TT + row) * RW + g * 16 + cosel] = p[0];
            }
        }
    }
}
__device__ __forceinline__ void s5_combine(const Args& a, int G) {
    const bf16* UX = (const bf16*)(a.ws + WS_UX); bf16* YB = (bf16*)(a.ws + WS_YB); const float* YF = a.out; const float* Dk = a.in[I_SD];
    for (size_t i = (size_t)blockIdx.x * NTHREADS + threadIdx.x; i < (size_t)TT * (RW / 8); i += (size_t)G * NTHREADS) {
        const size_t row = i >> 6; const int c8 = (int)(i & 63) * 8, g = c8 >> 4, ci0 = c8 & 15;
        const v4u uw = *(const v4u*)(UX + ((size_t)g * (TT / 16) + (row >> 4)) * 512 + (row & 15) * 16 + ci0);
        const float uu[8] = {bf_lo(uw.x), bf_hi(uw.x), bf_lo(uw.y), bf_hi(uw.y), bf_lo(uw.z), bf_hi(uw.z), bf_lo(uw.w), bf_hi(uw.w)};
        const f32x4 f0 = *(const f32x4*)(YF + row * RW + c8), f1 = *(const f32x4*)(YF + row * RW + c8 + 4);
        const f32x4 b0 = *(const f32x4*)(YF + ((size_t)TT + row) * RW + c8), b1 = *(const f32x4*)(YF + ((size_t)TT + row) * RW + c8 + 4);
        float y[8];
#pragma unroll
        for (int j = 0; j < 4; ++j) { y[j] = gelu_tanh(Dk[c8 + j] * uu[j] + f0[j] + b0[j]); y[4 + j] = gelu_tanh(Dk[c8 + 4 + j] * uu[4 + j] + f1[j] + b1[j]); }
        *(v4u*)(YB + row * RW + c8) = (v4u){pk2(y[0], y[1]), pk2(y[2], y[3]), pk2(y[4], y[5]), pk2(y[6], y[7])};
    }
}
__device__ __forceinline__ void ffn_fixup(const Args& a, int G) {
    const bf16* ZB = (const bf16*)(a.ws + WS_ZB); bf16* ACT = (bf16*)(a.ws + WS_ACT); const float* cw = a.in[I_CONVW]; const float* cb = a.in[I_CONVB];
    constexpr int NBLK = TT / 64, CPR = DFF / 4;
    for (int i = blockIdx.x * NTHREADS + threadIdx.x; i < NBLK * 2 * CPR; i += G * NTHREADS) {
        const int c = (i % CPR) * 4, e = (i / CPR) & 1, blk = i / (2 * CPR);
        const bool seq_first = (blk & 31) == 0, seq_last = (blk & 31) == 31;
        const bf16* zp; const bf16* zc; const bf16* zn; bool hp = true, hn = true; int row;
        if (e == 0) { row = blk * 64; zc = ZB + ((size_t)blk * 4 + 0) * NUP; zn = ZB + ((size_t)blk * 4 + 1) * NUP; zp = ZB + ((size_t)(blk - 1) * 4 + 3) * NUP; hp = !seq_first; if (!hp) zp = zc; }
        else { row = blk * 64 + 63; zc = ZB + ((size_t)blk * 4 + 3) * NUP; zp = ZB + ((size_t)blk * 4 + 2) * NUP; zn = ZB + ((size_t)(blk + 1) * 4 + 0) * NUP; hn = !seq_last; if (!hn) zn = zc; }
        float act[4];
        const v2u pv = *(const v2u*)(zp + c), cvv = *(const v2u*)(zc + c), nv = *(const v2u*)(zn + c);
        const v2u pg = *(const v2u*)(zp + DFF + c), cgv = *(const v2u*)(zc + DFF + c), ng = *(const v2u*)(zn + DFF + c);
        const float fpv[4] = {bf_lo(pv.x), bf_hi(pv.x), bf_lo(pv.y), bf_hi(pv.y)}, fcv[4] = {bf_lo(cvv.x), bf_hi(cvv.x), bf_lo(cvv.y), bf_hi(cvv.y)}, fnv[4] = {bf_lo(nv.x), bf_hi(nv.x), bf_lo(nv.y), bf_hi(nv.y)};
        const float fpg[4] = {bf_lo(pg.x), bf_hi(pg.x), bf_lo(pg.y), bf_hi(pg.y)}, fcg[4] = {bf_lo(cgv.x), bf_hi(cgv.x), bf_lo(cgv.y), bf_hi(cgv.y)}, fng[4] = {bf_lo(ng.x), bf_hi(ng.x), bf_lo(ng.y), bf_hi(ng.y)};
#pragma unroll
        for (int j = 0; j < 4; ++j) {
            const float v = cw[c + j] * (hp ? fpv[j] : 0.f) + cw[NUP + c + j] * fcv[j] + cw[2 * NUP + c + j] * (hn ? fnv[j] : 0.f) + cb[c + j];
            const float gt = cw[DFF + c + j] * (hp ? fpg[j] : 0.f) + cw[NUP + DFF + c + j] * fcg[j] + cw[2 * NUP + DFF + c + j] * (hn ? fng[j] : 0.f) + cb[DFF + c + j];
            act[j] = gelu_tanh(gt) * v;
        }
        *(v2u*)(ACT + (size_t)row * DFF + c) = (v2u){pk2(act[0], act[1]), pk2(act[2], act[3])};
    }
}
__device__ __forceinline__ void final_norm(const Args& a, int wave, int lane, int G) {
    const GAS f32x4* gn = (const GAS f32x4*)a.in[I_NFIN] + lane;
    f32x4 gv[4];
#pragma unroll
    for (int j = 0; j < 4; ++j) gv[j] = gn[64 * j];
    for (int m = blockIdx.x * NWAVES + wave; m < TT; m += G * NWAVES) {
        GAS f32x4* xr = (GAS f32x4*)(a.out + (size_t)m * DM) + lane;
        f32x4 v[4]; float s = 0.f;
#pragma unroll
        for (int j = 0; j < 4; ++j) { v[j] = xr[64 * j]; s += (v[j].x * v[j].x + v[j].y * v[j].y) + (v[j].z * v[j].z + v[j].w * v[j].w); }
        const float rinv = 1.0f / sqrtf(wave_sum(s) * (1.0f / DM) + EPS);
#pragma unroll
        for (int j = 0; j < 4; ++j) xr[64 * j] = v[j] * rinv * gv[j];
    }
}

__global__ void __launch_bounds__(NTHREADS, 2) hybrid_fwd(Args args) {
    extern __shared__ __attribute__((aligned(16))) unsigned char lds[];
    LAS unsigned char* L = (LAS unsigned char*)lds;
    volatile LAS unsigned* MISC = (volatile LAS unsigned*)(L + MISC_OFF);
    const int tid = threadIdx.x, lane = tid & 63, wave = __builtin_amdgcn_readfirstlane(tid >> 6);
    const int G = gridDim.x; const int bx = blockIdx.x; const int vcu = (G % 8 == 0) ? (bx % 8) * (G / 8) + bx / 8 : bx;
    unsigned char* ws = args.ws;
    for (int u = tid; u < (LDS_BYTES - LDSCTL_OFF) / 4; u += NTHREADS) ((LAS unsigned*)(L + LDSCTL_OFF))[u] = 0u;
    __syncthreads();
    XcdBarrier bar; bar.bar = (unsigned*)(ws + WS_CTL) + CW_BAR; bar.x = 0; bar.st = nullptr;
    if (N_LAUNCHES == 1) bar = xcd_barrier_post((unsigned*)(ws + WS_CTL) + CW_BAR, MISC + 8);
    const int lo = args.ph_lo, hi = args.ph_hi;
#ifndef MK_PHASE_MASK
#define MK_PHASE_MASK 0x7ff
#endif
#define IN(k) (((MK_PHASE_MASK >> (k)) & 1) && lo <= (k) && (k) < hi)
#define SEAM(k) do { if (IN(k) && IN((k) + 1)) xcd_barrier(bar); } while (0)

    if (IN(0)) { p0_prologue(args, L, wave, lane, vcu, G); } SEAM(0);
    if (IN(1)) {
        pg8::Gemm g{(const bf16*)(ws + WS_H1), (const bf16*)(ws + WS_WIN), TT, INW, DM, DM, DM}; pg8::StaticOrder S; S.init(TT, INW, G, bx);
        EpiIn E{(bf16*)(ws + WS_Q), (bf16*)(ws + WS_K), (bf16*)(ws + WS_V), (bf16*)(ws + WS_G), (bf16*)(ws + WS_UX), (const float*)(ws + WS_ROT), (const float*)(ws + WS_ROT) + SEQ * 64};
        pg8::gemm_phase<EpiIn, pg8::StaticOrder, true>(L, g, S, E);
    } SEAM(1);
    if (IN(2)) { ret_naive(args, L, G); } SEAM(2);
    if (IN(3)) { s5_naive(args, wave, lane, G); } SEAM(3);
    if (IN(4)) { s5_combine(args, G); } SEAM(4);
    if (IN(5)) {
        pg8::Gemm g{(const bf16*)(ws + WS_YB), (const bf16*)(ws + WS_WGLU), TT, RW, RW, RW, RW}; pg8::StaticOrder S; S.init(TT, RW, G, bx);
        EpiGlu E{(const bf16*)(ws + WS_YB), args.in[I_GLUB], (bf16*)(ws + WS_MIX)};
        pg8::gemm_phase<EpiGlu, pg8::StaticOrder, true>(L, g, S, E);
    } SEAM(5);
    if (IN(6)) {
        pg8::Gemm g{(const bf16*)(ws + WS_MIX), (const bf16*)(ws + WS_WOUT), TT, DM, DM, DM, DM}; pg8::StaticOrder S; S.init(TT, DM, G, bx);
        EpiOut E{args.in[I_XP], args.in[I_XS], args.out, (bf16*)(ws + WS_X2B), (float*)(ws + WS_SS1)};
        pg8::gemm_phase<EpiOut, pg8::StaticOrder, true>(L, g, S, E);
    } SEAM(6);
    if (IN(7)) {
        pg8::Gemm g{(const bf16*)(ws + WS_X2B), (const bf16*)(ws + WS_WUP), TT, NUP, DM, DM, DM}; pg8::StaticOrder S; S.init(TT, NUP, G, bx);
        EpiUp E{(bf16*)(ws + WS_ACT), (bf16*)(ws + WS_ZB), (const float*)(ws + WS_SS1), args.in[I_CONVW], args.in[I_CONVB]};
        pg8::gemm_phase<EpiUp, pg8::StaticOrder, true>(L, g, S, E);
    } SEAM(7);
    if (IN(8)) { ffn_fixup(args, G); } SEAM(8);
    if (IN(9)) {
        pg8::Gemm g{(const bf16*)(ws + WS_ACT), (const bf16*)(ws + WS_WDN), TT, DM, DFF, DFF, DFF}; pg8::StaticOrder S; S.init(TT, DM, G, bx);
        EpiDown E{args.out};
        pg8::gemm_phase<EpiDown, pg8::StaticOrder, true>(L, g, S, E);
    } SEAM(9);
    if (IN(10)) { final_norm(args, wave, lane, G); }
#undef IN
#undef SEAM
}

extern "C" void kernel_launch(void* const* d_in, const int* in_sizes, int n_in, void* d_out, int out_size, void* d_ws, size_t ws_size, hipStream_t stream) {
    static int grid = 0;
    if (grid == 0) {
        if (n_in != 22 || out_size != TT * DM || ws_size < WS_END) { fprintf(stderr, "kernel_launch: unexpected shapes (n_in %d out %d ws %zu, need ws >= %zu)\n", n_in, out_size, ws_size, (size_t)WS_END); grid = -1; return; }
        int dev = 0, cus = 0, per_cu = 0;
        if (hipGetDevice(&dev) != hipSuccess || hipDeviceGetAttribute(&cus, hipDeviceAttributeMultiprocessorCount, dev) != hipSuccess) { grid = -1; return; }
        if (hipFuncSetAttribute((const void*)hybrid_fwd, hipFuncAttributeMaxDynamicSharedMemorySize, LDS_BYTES) != hipSuccess) { fprintf(stderr, "kernel_launch: hipFuncSetAttribute failed\n"); grid = -1; return; }
        if (hipOccupancyMaxActiveBlocksPerMultiprocessor(&per_cu, (const void*)hybrid_fwd, NTHREADS, LDS_BYTES) != hipSuccess || per_cu < 1)
            fprintf(stderr, "kernel_launch: occupancy query reports %d workgroups per CU\n", per_cu);
        (void)hipGetLastError();
        grid = cus;
    }
    if (grid < 0) return;
    if (hipMemsetAsync((char*)d_ws + WS_CTL, 0, CTL_ZERO_BYTES, stream) != hipSuccess) { fprintf(stderr, "kernel_launch: memset failed\n"); return; }
    Args a{};
    for (int i = 0; i < 22; ++i) a.in[i] = (const float*)d_in[i];
    a.out = (float*)d_out; a.ws = (unsigned char*)d_ws;
    if (N_LAUNCHES == 1) { a.ph_lo = 0; a.ph_hi = N_PHASES; hipLaunchKernelGGL(hybrid_fwd, dim3(grid), dim3(NTHREADS), LDS_BYTES, stream, a); }
    else for (int p = 0; p < N_PHASES; ++p) { a.ph_lo = p; a.ph_hi = p + 1; hipLaunchKernelGGL(hybrid_fwd, dim3(grid), dim3(NTHREADS), LDS_BYTES, stream, a); }
}
```

```cpp
#include <hip/hip_runtime.h>
#include <cstdio>
#include <cstdint>

#ifndef MK_WGM1
#define MK_WGM1 4
#endif
#ifndef MK_WGM5
#define MK_WGM5 4
#endif
#ifndef MK_WGM6
#define MK_WGM6 4
#endif
#ifndef MK_WGM7
#define MK_WGM7 4
#endif
#ifndef MK_WGM9
#define MK_WGM9 4
#endif
#ifndef MK_N_LAUNCHES
#define MK_N_LAUNCHES 1
#endif

namespace pg8 {
#define PG8_LAS __attribute__((address_space(3)))
typedef unsigned short bf16_t;
typedef short bf16x8 __attribute__((ext_vector_type(8)));
typedef float f32x4 __attribute__((ext_vector_type(4)));
typedef unsigned u32x4 __attribute__((ext_vector_type(4)));
typedef unsigned u32x2 __attribute__((ext_vector_type(2)));
constexpr int BM = 256, BK = 64, HALF = 128, HTB = HALF * BK * 2, STAGE_BYTES = 8 * HTB, NXCD = 8;

__host__ __device__ __forceinline__ int lds_byte(int r, int c) { const int st = (r >> 4) * 2 + (c >> 5), rr = r & 15, cc = c & 31, ob = rr * 64 + cc * 2; return st * 1024 + (ob ^ (((ob >> 9) & 1) << 5)); }
__host__ __device__ __forceinline__ void stage_rc(int b, int& R, int& C) { const int st = b / 1024, sb = b % 1024, swz = sb ^ (((sb >> 9) & 1) << 5); R = (st >> 1) * 16 + swz / 64; C = (st & 1) * 32 + (swz % 64) / 2; }
__host__ __device__ __forceinline__ int perm32(int rho) { const int n = rho >> 4, i = rho & 15; return 8 * (i >> 2) + 4 * n + (i & 3); }

struct Unit { int pm, pn; };
struct Gemm { const bf16_t* A; const bf16_t* Bt; int M, N, K, lda, ldb; bool bimg = false; bool a_gm = false; };

struct StaticOrder {
    int nM, nN, nwg, G, c, WGM;
    __host__ __device__ void init(int M, int N, int G_, int c_, int wgm = 4) { nM = M / BM; nN = N / BM; nwg = nM * nN; G = G_; c = c_; WGM = wgm; }
    __host__ __device__ void map(int wgid, Unit& u) const {
        { const int q = nwg / NXCD, r = nwg % NXCD, xcd = wgid % NXCD, off = wgid / NXCD; wgid = (xcd < r ? xcd * (q + 1) : r * (q + 1) + (xcd - r) * q) + off; }
        const int nig = WGM * nN, gid = wgid / nig, fm = gid * WGM, gsz = (nM - fm) < WGM ? (nM - fm) : WGM;
        u.pm = fm + ((wgid % nig) % gsz); u.pn = (wgid % nig) / gsz;
    }
    __host__ __device__ bool next(int i, Unit& u) const {
        const long L = (long)i * G + c; if (L >= nwg) return false;
        map((int)L, u); return true;
    }
    __device__ __forceinline__ void a_ready(const Unit&) const {}
    __device__ __forceinline__ void done(const Unit&) const {}
};

__device__ __forceinline__ unsigned cvt_pk_bf16(float lo, float hi) { unsigned r; asm volatile("v_cvt_pk_bf16_f32 %0, %1, %2" : "=v"(r) : "v"(lo), "v"(hi)); return r; }

template <class Epi, class Sched, bool ALIGN_EPI, bool ROWPERM = false>
__device__ __forceinline__ void gemm_phase(PG8_LAS unsigned char* lds, const Gemm g, const Sched& S, const Epi& E) {
    const int tid = threadIdx.x, wid = __builtin_amdgcn_readfirstlane(tid >> 6), lane = tid & 63, wr = wid >> 2, wc = wid & 3, fr = lane & 15, fq = lane >> 4;
    const int K = g.K, nt = K / BK;
    unsigned voffA[2], voffB[2];
#pragma unroll
    for (int i = 0; i < 2; ++i) { int R, C; stage_rc(tid * 16 + i * 8192, R, C); const int Rb = (R & ~31) + perm32(R & 31);
        const int Ra = ROWPERM ? ((R & ~63) + 4 * (R & 15) + ((R >> 4) & 3)) : R;
        voffA[i] = g.a_gm ? (unsigned)(((C >> 4) * g.M + Ra) * 16 + (C & 15)) * 2u : (unsigned)(Ra * g.lda + C) * 2u; voffB[i] = g.bimg ? (unsigned)(tid * 16 + i * 8192) : (unsigned)(Rb * g.ldb + C) * 2u; }
    const size_t kstepB = g.bimg ? (size_t)HTB : (size_t)(BK * 2), kstep = g.a_gm ? (size_t)4 * g.M * 16 * 2 : (size_t)(BK * 2);
    const size_t hstepA = g.a_gm ? (size_t)HALF * 16 * 2 : (size_t)HALF * g.lda * 2, hstepB = g.bimg ? (size_t)(g.K / BK) * HTB : (size_t)HALF * g.ldb * 2;
    const size_t tstepA = 2 * hstepA, tstepB = 2 * hstepB;
    const unsigned ldsw = (unsigned)wid * 1024u;
    const int aoff = lds_byte(wr * 64 + fr, fq * 8), boff = lds_byte(wc * 32 + fr, fq * 8);
#define PG8_SA(b, h) (((b) * 2 + (h)) * HTB)
#define PG8_SB(b, h) ((4 + (b) * 2 + (h)) * HTB)
#define PG8_STAGE(bufoff, gbase, voff) do { _Pragma("unroll") for (int _i = 0; _i < 2; ++_i) \
        __builtin_amdgcn_global_load_lds((const unsigned*)((const char*)(gbase) + (voff)[_i]), (PG8_LAS unsigned*)(lds + (bufoff) + ldsw + _i * 8192), 16, 0, 0); } while (0)
#define PG8_LDA(dst, b, h) do { _Pragma("unroll") for (int m = 0; m < 4; ++m) _Pragma("unroll") for (int k = 0; k < 2; ++k) dst[m][k] = *(const PG8_LAS bf16x8*)(lds + PG8_SA(b, h) + aoff + m * 2048 + k * 1024); } while (0)
#define PG8_LDB(dst, b, h) do { _Pragma("unroll") for (int n = 0; n < 2; ++n) _Pragma("unroll") for (int k = 0; k < 2; ++k) dst[n][k] = *(const PG8_LAS bf16x8*)(lds + PG8_SB(b, h) + boff + n * 2048 + k * 1024); } while (0)
#define PG8_MMA(ai, bj, At, Bt) do { __builtin_amdgcn_s_setprio(1); _Pragma("unroll") for (int m = 0; m < 4; ++m) _Pragma("unroll") for (int n = 0; n < 2; ++n) _Pragma("unroll") for (int k = 0; k < 2; ++k) \
        acc[ai][bj][m][n] = __builtin_amdgcn_mfma_f32_16x16x32_bf16(Bt[n][k], At[m][k], acc[ai][bj][m][n], 0, 0, 0); __builtin_amdgcn_s_setprio(0); } while (0)
#define PG8_WAIT_V(n) asm volatile("s_waitcnt vmcnt(" #n ")" ::: "memory")
#define PG8_WAIT_L(n) asm volatile("s_waitcnt lgkmcnt(" #n ")" ::: "memory")
#define PG8_BAR __builtin_amdgcn_s_barrier()
#define PG8_SCHED __builtin_amdgcn_sched_barrier(0)
    Unit cur, nxt, prev; int ui = 0;
    if (!S.next(0, cur)) return;
    prev = cur;
    typename Epi::Carry carry;
    f32x4 acc[2][2][4][2];
#pragma unroll
    for (int a = 0; a < 2; ++a)
#pragma unroll
        for (int b = 0; b < 2; ++b)
#pragma unroll
            for (int m = 0; m < 4; ++m)
#pragma unroll
                for (int n = 0; n < 2; ++n) acc[a][b][m][n] = (f32x4){0.f, 0.f, 0.f, 0.f};
    bf16x8 At[4][2], B0[2][2], B1[2][2];
    const char* cA = (const char*)g.A + (size_t)cur.pm * tstepA; const char* cB = (const char*)g.Bt + (size_t)cur.pn * tstepB;
    S.a_ready(cur);
    PG8_STAGE(PG8_SB(0, 0), cB, voffB); PG8_STAGE(PG8_SB(0, 1), cB + hstepB, voffB); PG8_STAGE(PG8_SA(0, 0), cA, voffA); PG8_STAGE(PG8_SA(0, 1), cA + hstepA, voffA);
    if (wr == 1) PG8_BAR;
    PG8_WAIT_V(2); PG8_BAR;
    PG8_STAGE(PG8_SB(1, 0), cB + kstepB, voffB); PG8_STAGE(PG8_SA(1, 0), cA + kstep, voffA); PG8_STAGE(PG8_SB(1, 1), cB + hstepB + kstepB, voffB);
    PG8_WAIT_V(6); PG8_BAR;
    for (;;) {
        const bool has_next = S.next(ui + 1, nxt);
        const char* nA = has_next ? (const char*)g.A + (size_t)nxt.pm * tstepA : cA; const char* nB = has_next ? (const char*)g.Bt + (size_t)nxt.pn * tstepB : cB;
#pragma unroll 1
        for (int t = 0; t < nt; t += 2) {
            const bool last = (t == nt - 2);
            const bool pend = Epi::NDEFER > 0 && t == 0 && ui > 0;
            const char* a1 = cA + (size_t)(t + 1) * kstep;
            const char* a2 = last ? nA : cA + (size_t)(t + 2) * kstep; const char* b2 = last ? nB : cB + (size_t)(t + 2) * kstepB;
            const char* a3 = a2 + kstep; const char* b3 = b2 + kstepB;
            if (last && has_next) S.a_ready(nxt);
            PG8_LDB(B0, 0, 0); PG8_LDB(B1, 0, 1); PG8_SCHED; PG8_LDA(At, 0, 0); PG8_STAGE(PG8_SA(1, 1), a1 + hstepA, voffA);
            PG8_WAIT_V(8); PG8_WAIT_L(0); PG8_BAR; PG8_MMA(0, 0, At, B0); PG8_MMA(0, 1, At, B1); PG8_BAR; PG8_SCHED;
            if constexpr (Epi::NDEFER > 0) { if (pend) { int fr_ = fr, fq_ = fq; asm volatile("" : "+v"(fr_), "+v"(fq_)); E.flush(carry, 0, prev, wr, wc, fr_, fq_); } }
            PG8_LDA(At, 0, 1); PG8_STAGE(PG8_SB(0, 0), b2, voffB); PG8_STAGE(PG8_SB(0, 1), b2 + hstepB, voffB); PG8_STAGE(PG8_SA(0, 0), a2, voffA);
            PG8_WAIT_V(8); PG8_WAIT_L(0); PG8_BAR; PG8_MMA(1, 0, At, B0); PG8_MMA(1, 1, At, B1); PG8_BAR; PG8_SCHED;
            if constexpr (Epi::NDEFER > 0) { if (pend) { int fr_ = fr, fq_ = fq; asm volatile("" : "+v"(fr_), "+v"(fq_)); E.flush(carry, 1, prev, wr, wc, fr_, fq_); } }
            PG8_LDB(B0, 1, 0); PG8_LDB(B1, 1, 1); PG8_SCHED; PG8_LDA(At, 1, 0); PG8_STAGE(PG8_SA(0, 1), a2 + hstepA, voffA);
            PG8_WAIT_V(8); PG8_WAIT_L(0); PG8_BAR; PG8_MMA(0, 0, At, B0); PG8_MMA(0, 1, At, B1); PG8_BAR; PG8_SCHED;
            if constexpr (Epi::NDEFER > 0) { if (pend && Epi::NDEFER > 2) E.flush(carry, 2, prev, wr, wc, fr, fq); }
            PG8_LDA(At, 1, 1); PG8_STAGE(PG8_SB(1, 0), b3, voffB); PG8_STAGE(PG8_SB(1, 1), b3 + hstepB, voffB); PG8_STAGE(PG8_SA(1, 0), a3, voffA);
            PG8_WAIT_V(8); PG8_WAIT_L(0); PG8_BAR; PG8_MMA(1, 0, At, B0); PG8_MMA(1, 1, At, B1); PG8_BAR; PG8_SCHED;
            if constexpr (Epi::NDEFER > 0) { if (pend && Epi::NDEFER > 3) E.flush(carry, 3, prev, wr, wc, fr, fq); }
        }
        if constexpr (ALIGN_EPI) { if (wr == 0) PG8_BAR; }
        { int fr_ = fr, fq_ = fq; asm volatile("" : "+v"(fr_), "+v"(fq_));
          if constexpr (Epi::NDEFER > 0) E.run(acc, cur, wr, wc, fr_, fq_, carry, has_next); else E(acc, cur, wr, wc, fr_, fq_); }
        S.done(cur); prev = cur;
        if (!has_next) break;
#pragma unroll
        for (int a = 0; a < 2; ++a)
#pragma unroll
            for (int b = 0; b < 2; ++b)
#pragma unroll
                for (int m = 0; m < 4; ++m)
#pragma unroll
                    for (int n = 0; n < 2; ++n) acc[a][b][m][n] = (f32x4){0.f, 0.f, 0.f, 0.f};
        cur = nxt; cA = nA; cB = nB; ++ui;
        if constexpr (ALIGN_EPI) { if (wr == 1) PG8_BAR; }
    }
    PG8_WAIT_V(0);
    if constexpr (!ALIGN_EPI) { if (wr == 0) PG8_BAR; }
    PG8_BAR;
#undef PG8_SA
#undef PG8_SB
#undef PG8_STAGE
#undef PG8_LDA
#undef PG8_LDB
#undef PG8_MMA
#undef PG8_WAIT_V
#undef PG8_WAIT_L
#undef PG8_BAR
#undef PG8_SCHED
}
}

constexpr int NWAVES = 8, NTHREADS = NWAVES * 64;
constexpr int N_LAUNCHES = MK_N_LAUNCHES;
constexpr int N_PHASES = 10;
constexpr int DM = 1024, SEQ = 2048, NSEQ_P = 8, NSEQ = 24, T_P = NSEQ_P * SEQ, TT = NSEQ * SEQ;
constexpr int RW = 512, NHEAD = 4, DH = 128, INW = 2560, DFF = 2816, NUP = 2 * DFF;
constexpr int SG = 32, SCH = 16, SNS = 64;
constexpr float EPS = 1e-6f;

typedef unsigned short bf16;
typedef float f32x4 __attribute__((ext_vector_type(4)));
typedef unsigned v4u __attribute__((ext_vector_type(4)));
typedef unsigned v2u __attribute__((ext_vector_type(2)));
#define GAS __attribute__((address_space(1)))
#define LAS __attribute__((address_space(3)))
typedef GAS unsigned gu32;
#define RLX_AGENT __ATOMIC_RELAXED, __HIP_MEMORY_SCOPE_AGENT
#define LDS_WAIT() asm volatile("s_waitcnt lgkmcnt(0)" ::: "memory")

constexpr size_t MiB = 1u << 20;
constexpr size_t WS_CTL = 0, CTL_ZERO_BYTES = 1 * MiB;
constexpr size_t WS_ROT = 1 * MiB;
constexpr size_t WS_SS1 = 256 * 1024, WS_SS2 = 512 * 1024;
constexpr int CW_UXRDY = 6144;
constexpr int CW_PANEL = 8192;
constexpr size_t WS_WIN = 4 * MiB, WS_WGLU = 9 * MiB, WS_WOUT = 10 * MiB, WS_WUP = 12 * MiB, WS_WDN = 23 * MiB;
constexpr size_t WS_BTY = 29 * MiB, WS_BTE = 37 * MiB, WS_A16 = 41 * MiB;
constexpr size_t WS_H1 = 48 * MiB;
constexpr size_t WS_RMS1 = 2 * MiB;
constexpr size_t WS_Q = 144 * MiB, WS_K = 192 * MiB, WS_V = 240 * MiB, WS_G = 288 * MiB;
constexpr size_t WS_UX = 336 * MiB;
constexpr size_t WS_YB = 432 * MiB;
constexpr size_t WS_ACT = 48 * MiB;
constexpr size_t WS_X2B = 312 * MiB;
constexpr size_t WS_ZB = 408 * MiB;
constexpr size_t WS_END = 480 * MiB;
static_assert(WS_ACT + (size_t)TT * DFF * 2 <= WS_X2B && WS_X2B + (size_t)TT * DM * 2 <= WS_ZB && WS_ZB + (size_t)768 * 4 * NUP * 2 <= WS_END, "ws map");
constexpr int CW_BAR = 1024;

constexpr int RING_BYTES = 131072;
constexpr int LDSCTL_OFF = RING_BYTES, MISC_OFF = LDSCTL_OFF + 320;
constexpr int LDS_BYTES = 147456;

__device__ __forceinline__ unsigned f2bf(float f) { unsigned u = __builtin_bit_cast(unsigned, f); return (u + 0x7fffu + ((u >> 16) & 1u)) >> 16; }
__device__ __forceinline__ unsigned pk2(float lo, float hi) { return f2bf(lo) | (f2bf(hi) << 16); }
__device__ __forceinline__ float bf_lo(unsigned w) { return __builtin_bit_cast(float, w << 16); }
__device__ __forceinline__ float bf_hi(unsigned w) { return __builtin_bit_cast(float, w & 0xffff0000u); }
__device__ __forceinline__ float gelu_tanh(float x) {
    const float t = x * (1.0f + 0.044715f * x * x) * (-2.0f * 0.7978845608028654f * 1.4426950408889634f);
    return x * __builtin_amdgcn_rcpf(1.0f + __builtin_amdgcn_exp2f(t));
}
__device__ __forceinline__ float sigmoidf_(float x) { return __builtin_amdgcn_rcpf(1.0f + __builtin_amdgcn_exp2f(-1.4426950408889634f * x)); }
__device__ __forceinline__ f32x4 gelu_mul4(f32x4 g, f32x4 v) {
    const float c1 = -2.0f * 0.7978845608028654f * 1.4426950408889634f, c2 = c1 * 0.044715f;
    const f32x4 u = g * g, p = u * c2 + c1, t = g * p;
    f32x4 d; d[0] = __builtin_amdgcn_exp2f(t[0]); d[1] = __builtin_amdgcn_exp2f(t[1]); d[2] = __builtin_amdgcn_exp2f(t[2]); d[3] = __builtin_amdgcn_exp2f(t[3]);
    d = d + 1.0f;
    f32x4 r; r[0] = __builtin_amdgcn_rcpf(d[0]); r[1] = __builtin_amdgcn_rcpf(d[1]); r[2] = __builtin_amdgcn_rcpf(d[2]); r[3] = __builtin_amdgcn_rcpf(d[3]);
    return (g * v) * r;
}
__device__ __forceinline__ f32x4 gelu4(f32x4 g) {
    const float c1 = -2.0f * 0.7978845608028654f * 1.4426950408889634f, c2 = c1 * 0.044715f;
    const f32x4 u = g * g, p = u * c2 + c1, t = g * p;
    f32x4 d; d[0] = __builtin_amdgcn_exp2f(t[0]); d[1] = __builtin_amdgcn_exp2f(t[1]); d[2] = __builtin_amdgcn_exp2f(t[2]); d[3] = __builtin_amdgcn_exp2f(t[3]);
    d = d + 1.0f;
    f32x4 r; r[0] = __builtin_amdgcn_rcpf(d[0]); r[1] = __builtin_amdgcn_rcpf(d[1]); r[2] = __builtin_amdgcn_rcpf(d[2]); r[3] = __builtin_amdgcn_rcpf(d[3]);
    return g * r;
}
__device__ __forceinline__ f32x4 sigmoid4(f32x4 x) {
    const f32x4 t = x * (-1.4426950408889634f);
    f32x4 d; d[0] = __builtin_amdgcn_exp2f(t[0]); d[1] = __builtin_amdgcn_exp2f(t[1]); d[2] = __builtin_amdgcn_exp2f(t[2]); d[3] = __builtin_amdgcn_exp2f(t[3]);
    d = d + 1.0f;
    return (f32x4){__builtin_amdgcn_rcpf(d[0]), __builtin_amdgcn_rcpf(d[1]), __builtin_amdgcn_rcpf(d[2]), __builtin_amdgcn_rcpf(d[3])};
}
__device__ __forceinline__ float wave_sum(float v) {
#pragma unroll
    for (int o = 1; o < 64; o <<= 1) v += __shfl_xor(v, o);
    return v;
}

#define XB_TMO      128
#define XB_XCNT(j)  (256  + 64 * (j))
#define XB_XSUB(j)  (1280 + 64 * (j))
#define XB_XGEN(j)  (2304 + 64 * (j))
#define XB_TOP      3328
#define XB_TOPGEN   3392
#define XCD_BAR_WORDS 3456
#define XB_SPIN_CAP (1u << 24)
__device__ __forceinline__ unsigned xb_ld(unsigned* p)              { return __hip_atomic_load(p, __ATOMIC_RELAXED, __HIP_MEMORY_SCOPE_AGENT); }
__device__ __forceinline__ unsigned xb_add(unsigned* p, unsigned v) { return __hip_atomic_fetch_add(p, v, __ATOMIC_RELAXED, __HIP_MEMORY_SCOPE_AGENT); }
__device__ __forceinline__ unsigned xb_xcc_id() { return (unsigned)__builtin_amdgcn_s_getreg((3 << 11) | 20) & 0xFu; }
#define XB_SPIN(cond, bar) do { unsigned _sp = 0; while (cond) { __builtin_amdgcn_s_sleep(1); \
    if ((++_sp & 255u) == 0u) { if (xb_ld(&(bar)[XB_TMO])) break; if (_sp > XB_SPIN_CAP) { atomicAdd(&(bar)[XB_TMO], 1u); break; } } } } while (0)
struct XcdBarrier { unsigned* bar; unsigned x; volatile LAS unsigned* st; };
__device__ __forceinline__ XcdBarrier xcd_barrier_post(unsigned* bar, volatile LAS unsigned* st) {
    XcdBarrier b; b.bar = bar; b.x = xb_xcc_id(); b.st = st;
    if (threadIdx.x == 0) (void)xb_add(&bar[XB_XCNT(b.x)], 1u);
    return b;
}
__device__ __forceinline__ void xcd_barrier_complete(unsigned* bar, unsigned x, unsigned& nloc, unsigned& nx) {
    const unsigned G = gridDim.x * gridDim.y * gridDim.z;
    unsigned sum, cnt, mine, sp = 0u;
    for (;;) {
        sum = 0u; cnt = 0u; mine = 0u;
#pragma unroll
        for (unsigned j = 0; j < 16; ++j) { const unsigned c = xb_ld(&bar[XB_XCNT(j)]); sum += c; cnt += (c > 0u) ? 1u : 0u; mine = (j == x) ? c : mine; }
        if (sum == G) break;
        __builtin_amdgcn_s_sleep(1);
        if ((++sp & 255u) == 0u) { if (xb_ld(&bar[XB_TMO])) break; if (sp > XB_SPIN_CAP) { atomicAdd(&bar[XB_TMO], 1u); break; } }
    }
    nloc = mine > 0u ? mine : 1u; nx = cnt > 0u ? cnt : 1u;
}
__device__ __forceinline__ void xcd_barrier(const XcdBarrier& b) {
    asm volatile("s_waitcnt vmcnt(0)" ::: "memory");
    __syncthreads();
    if (threadIdx.x == 0) {
        unsigned* bar = b.bar;
        __builtin_amdgcn_s_waitcnt(0);
        unsigned nloc = b.st[0], nx = b.st[1];
        if (nloc == 0u) { xcd_barrier_complete(bar, b.x, nloc, nx); b.st[0] = nloc; b.st[1] = nx; }
        const unsigned old = xb_add(&bar[XB_XSUB(b.x)], 1u);
        const unsigned gen = old / nloc;
        if (old + 1u == (gen + 1u) * nloc) {
            __builtin_amdgcn_fence(__ATOMIC_RELEASE, "agent");
            asm volatile("s_waitcnt vmcnt(0)" ::: "memory");
            const unsigned og = xb_add(&bar[XB_TOP], 1u);
            const unsigned tg = og / nx;
            if (og + 1u == (tg + 1u) * nx) xb_add(&bar[XB_TOPGEN], 1u);
            else XB_SPIN(xb_ld(&bar[XB_TOPGEN]) == tg, bar);
            __builtin_amdgcn_fence(__ATOMIC_ACQUIRE, "agent");
            xb_add(&bar[XB_XGEN(b.x)], 1u);
            asm volatile("s_waitcnt vmcnt(0)" ::: "memory");
        } else {
            XB_SPIN(xb_ld(&bar[XB_XGEN(b.x)]) == gen, bar);
            __builtin_amdgcn_fence(__ATOMIC_ACQUIRE, "agent");
            asm volatile("s_waitcnt vmcnt(0)" ::: "memory");
        }
    }
    __syncthreads();
}

struct Args { const float* in[22]; float* out; unsigned char* ws; int ph_lo, ph_hi; };
enum { I_XP = 0, I_XS, I_NMIX, I_WIN, I_GN, I_LRE, I_LIM, I_LDT, I_BRE, I_BIM, I_CRE, I_CIM, I_SD, I_GLUW, I_GLUB, I_WOUT, I_NFFN, I_WUP, I_CONVW, I_CONVB, I_WDN, I_NFIN };

template <int MODE>
__device__ __forceinline__ int w_dst_row(int n) {
    if (MODE == 1) {
        if (n >= 2 * RW) return n;
        const int sec = n >> 9, hh = (n >> 7) & 3, d = n & 127, nb = d >> 6, j = d & 63;
        const int p = 32 * (j >> 4) + 8 * ((j >> 2) & 3) + 4 * nb + (j & 3);
        return sec * RW + hh * DH + p;
    } else if (MODE == 2) {
        const int gate = n >= DFF ? 1 : 0, c = n - gate * DFF;
        return (c >> 7) * 256 + gate * 128 + (c & 127);
    }
    return n;
}
template <int MODE>
__device__ __forceinline__ void p0_transpose_item(const float* W, int K, int N, bf16* WT, const float* kgain, LAS float* scr, int item, int lane) {
    const int nblk = N / 32, kb = item / nblk, nb = item % nblk, k0 = 64 * kb, n0 = 32 * nb;
#pragma unroll 8
    for (int i = 0; i < 32; ++i) { const int kk = 2 * i + (lane >> 5); float w = W[(size_t)(k0 + kk) * N + n0 + (lane & 31)]; if (MODE == 2) w *= kgain[k0 + kk]; scr[kk * 33 + (lane & 31)] = w; }
    LDS_WAIT(); asm volatile("" ::: "memory");
    const int c = lane & 7;
#pragma unroll
    for (int j = 0; j < 4; ++j) { const int n = (lane >> 3) + 8 * j; const LAS float* s = scr + (8 * c) * 33 + n;
        const int ng = n0 + n; float sc = 1.0f; if (MODE == 1) { if (ng >= RW && ng < 2 * RW) sc = 0.08838834764831845f; }
        v4u o; o.x = pk2(s[0 * 33] * sc, s[1 * 33] * sc); o.y = pk2(s[2 * 33] * sc, s[3 * 33] * sc); o.z = pk2(s[4 * 33] * sc, s[5 * 33] * sc); o.w = pk2(s[6 * 33] * sc, s[7 * 33] * sc);
        const int nd = w_dst_row<MODE>(ng), nl = nd & 127, x = nl & 31, slot = (nl & ~31) + 16 * ((x >> 2) & 1) + 4 * (x >> 3) + (x & 3);
        const int kk8 = k0 + 8 * c;
        *(GAS v4u*)(WT + ((size_t)(nd >> 7) * (K / 64) + (kk8 >> 6)) * 8192 + pg8::lds_byte(slot, kk8 & 63) / 2) = o; }
    LDS_WAIT(); asm volatile("" ::: "memory");
}
__device__ __forceinline__ const float* x_row(const Args& a, int m) { return m < T_P ? a.in[I_XP] + (size_t)m * DM : a.in[I_XS] + (size_t)(m - T_P) * DM; }

__device__ __forceinline__ void s5_build(const Args& a, LAS unsigned char* lds, int unit);
__device__ __forceinline__ void p0_prologue(const Args& a, LAS unsigned char* lds, int wave, int lane, int vcu, int G) {
    unsigned char* ws = a.ws;
    LAS float* scr = (LAS float*)(lds + wave * 16384);
    const bool split = (G & 1) == 0;
    const bool do_w = !split || (vcu & 1) == 1, do_h = !split || (vcu & 1) == 0;
    const int gw = (split ? (vcu >> 1) : vcu) * NWAVES + wave, NGW = (split ? G / 2 : G) * NWAVES;
    if (do_w) for (int un = split ? (vcu >> 1) : vcu; un < SG * 8; un += split ? G / 2 : G) s5_build(a, lds, un);
    constexpr int I_IN = (DM / 64) * (INW / 32), I_GLU = (RW / 64) * (RW / 32), I_OUT = (DM / 64) * (DM / 32), I_UP = (DM / 64) * (NUP / 32), I_DN = (DFF / 64) * (DM / 32);
    constexpr int NITEMS = I_IN + I_GLU + I_OUT + I_UP + I_DN;
    if (do_w) for (int it = gw; it < NITEMS; it += NGW) {
        int r = it;
        if (r < I_IN) { p0_transpose_item<1>(a.in[I_WIN], DM, INW, (bf16*)(ws + WS_WIN), nullptr, scr, r, lane); continue; } r -= I_IN;
        if (r < I_GLU) { p0_transpose_item<0>(a.in[I_GLUW], RW, RW, (bf16*)(ws + WS_WGLU), nullptr, scr, r, lane); continue; } r -= I_GLU;
        if (r < I_OUT) { p0_transpose_item<0>(a.in[I_WOUT], DM, DM, (bf16*)(ws + WS_WOUT), nullptr, scr, r, lane); continue; } r -= I_OUT;
        if (r < I_UP) { p0_transpose_item<2>(a.in[I_WUP], DM, NUP, (bf16*)(ws + WS_WUP), a.in[I_NFFN], scr, r, lane); continue; } r -= I_UP;
        p0_transpose_item<0>(a.in[I_WDN], DFF, DM, (bf16*)(ws + WS_WDN), nullptr, scr, r, lane);
    }
    if (do_h) {
        const GAS f32x4* gn = (const GAS f32x4*)a.in[I_NMIX] + lane;
        f32x4 gv[4];
#pragma unroll
        for (int j = 0; j < 4; ++j) gv[j] = gn[64 * j];
        for (int m = gw; m < TT; m += 2 * NGW) {
            const int m2 = m + NGW; const bool has2 = m2 < TT;
            const GAS f32x4* xr = (const GAS f32x4*)x_row(a, m) + lane; const GAS f32x4* xr2 = (const GAS f32x4*)x_row(a, has2 ? m2 : m) + lane;
            f32x4 v[4], v2[4]; float s = 0.f, s2 = 0.f;
#pragma unroll
            for (int j = 0; j < 4; ++j) { v[j] = xr[64 * j]; v2[j] = xr2[64 * j]; }
#pragma unroll
            for (int j = 0; j < 4; ++j) { s += (v[j].x * v[j].x + v[j].y * v[j].y) + (v[j].z * v[j].z + v[j].w * v[j].w); s2 += (v2[j].x * v2[j].x + v2[j].y * v2[j].y) + (v2[j].z * v2[j].z + v2[j].w * v2[j].w); }
            const float rms = sqrtf(wave_sum(s) * (1.0f / DM) + EPS), rms2 = sqrtf(wave_sum(s2) * (1.0f / DM) + EPS); const float rinv = 1.0f / rms, rinv2 = 1.0f / rms2;
            if (lane == 0) { ((float*)(ws + WS_RMS1))[m] = rms; if (has2) ((float*)(ws + WS_RMS1))[m2] = rms2; }
            GAS unsigned long long* o8 = (GAS unsigned long long*)((bf16*)(ws + WS_H1) + (size_t)m * DM) + lane;
#pragma unroll
            for (int j = 0; j < 4; ++j) o8[64 * j] = (unsigned long long)pk2(v[j].x * rinv * gv[j].x, v[j].y * rinv * gv[j].y) | ((unsigned long long)pk2(v[j].z * rinv * gv[j].z, v[j].w * rinv * gv[j].w) << 32);
            if (has2) { GAS unsigned long long* o82 = (GAS unsigned long long*)((bf16*)(ws + WS_H1) + (size_t)m2 * DM) + lane;
#pragma unroll
                for (int j = 0; j < 4; ++j) o82[64 * j] = (unsigned long long)pk2(v2[j].x * rinv2 * gv[j].x, v2[j].y * rinv2 * gv[j].y) | ((unsigned long long)pk2(v2[j].z * rinv2 * gv[j].z, v2[j].w * rinv2 * gv[j].w) << 32); }
        }
    }
    if (do_w) {
        const int gt = gw * 64 + lane, NGT = NGW * 64;
        float* rc = (float*)(ws + WS_ROT); float* rs = rc + SEQ * 64;
        for (int i = gt; i < SEQ * 64; i += NGT) {
            const int pos = i >> 6, f = i & 63;
            const float inv = exp2f(-(float)f * (13.287712379549449f / 64.0f));
            const float ang = (float)pos * inv; float sn, cs; sincosf(ang, &sn, &cs);
            rc[i] = cs; rs[i] = sn;
        }
    }
}

__device__ __forceinline__ void st16_wt(void* p, v4u w) { asm volatile("global_store_dwordx4 %0, %1, off sc1\n\ts_nop 1" :: "v"(p), "v"(w) : "memory"); }
struct P1Order {
    pg8::StaticOrder su, sr; int G, c; unsigned* cnt;
    __device__ __forceinline__ void init(int G_, int c_, unsigned* cnt_) { su.init(TT, 512, G_, c_, 4); sr.init(TT, 2048, G_, c_, 4); G = G_; c = c_; cnt = cnt_; }
    __device__ __forceinline__ bool next(int i, pg8::Unit& u) const {
        const int L = i * G + c; if (L >= 1920) return false;
        if (L < 384) { su.map(L, u); u.pn += 8; } else sr.map(L - 384, u);
        return true;
    }
    __device__ __forceinline__ void a_ready(const pg8::Unit&) const {}
    __device__ __forceinline__ void done(const pg8::Unit& u) const {
        if (u.pn >= 8) { asm volatile("s_waitcnt vmcnt(0)" ::: "memory");
            if ((threadIdx.x & 63) == 0) __hip_atomic_fetch_add(cnt + 64 * (u.pm >> 4), 1u, __ATOMIC_RELAXED, __HIP_MEMORY_SCOPE_AGENT); }
    }
};
struct S5ESubOrder {
    int G, c; const unsigned* cnt;
    __device__ __forceinline__ bool next(int i, pg8::Unit& u) const { const int L = i * G + c; if (L >= SG * 12) return false; u.pm = L; u.pn = L / 12; return true; }
    __device__ __forceinline__ void a_ready(const pg8::Unit& u) const {
        if (threadIdx.x < 64) {
            const unsigned* p = cnt + 64 * (u.pm % 12); unsigned sp = 0;
            while ((unsigned)__builtin_amdgcn_readfirstlane((int)__hip_atomic_load(p, __ATOMIC_RELAXED, __HIP_MEMORY_SCOPE_AGENT)) < 256u) { if (++sp > (1u << 22)) break; __builtin_amdgcn_s_sleep(2); }
            __builtin_amdgcn_fence(__ATOMIC_ACQUIRE, "agent");
            asm volatile("s_waitcnt vmcnt(0)" ::: "memory");
        }
        asm volatile("" ::: "memory"); __builtin_amdgcn_s_barrier(); asm volatile("" ::: "memory");
    }
    __device__ __forceinline__ void done(const pg8::Unit&) const {}
};
using pg8::Unit; using pg8::cvt_pk_bf16;
struct EpiIn {
    static constexpr int NDEFER = 0; struct Carry {};
    bf16 *Q, *Kk, *V, *Gt, *UX; const float* rotc; const float* rots;
    __device__ __forceinline__ void operator()(const f32x4 (&acc)[2][2][4][2], const Unit& u, int wr, int wc, int fr, int fq) const {
        const int sec = u.pn >> 1, half = u.pn & 1;
        const int row0 = u.pm * 256 + wr * 64 + fr;
        if (sec < 2) {
            bf16* dst = sec == 0 ? Q : Kk;
            const int f0 = 16 * wc + 4 * fq;
#pragma unroll
            for (int ai = 0; ai < 2; ++ai)
#pragma unroll
                for (int m = 0; m < 4; ++m) {
                    const int row = row0 + ai * 128 + m * 16, pos = row & (SEQ - 1);
                    const f32x4 c = *(const f32x4*)(rotc + pos * 64 + f0), s = *(const f32x4*)(rots + pos * 64 + f0);
#pragma unroll
                    for (int bj = 0; bj < 2; ++bj) {
                        const f32x4 x1 = acc[ai][bj][m][0], x2 = acc[ai][bj][m][1];
                        const f32x4 o1 = x1 * c - x2 * s, o2 = x1 * s + x2 * c;
                        v4u w; w.x = cvt_pk_bf16(o1[0], o1[1]); w.y = cvt_pk_bf16(o1[2], o1[3]); w.z = cvt_pk_bf16(o2[0], o2[1]); w.w = cvt_pk_bf16(o2[2], o2[3]);
                        *(v4u*)(dst + (size_t)row * RW + (half * 2 + bj) * DH + 32 * wc + 8 * fq) = w;
                    }
                }
        } else if (sec < 4) {
            bf16* dst = sec == 2 ? V : Gt;
#pragma unroll
            for (int ai = 0; ai < 2; ++ai)
#pragma unroll
                for (int m = 0; m < 4; ++m) {
                    const int row = row0 + ai * 128 + m * 16;
#pragma unroll
                    for (int bj = 0; bj < 2; ++bj) {
                        const f32x4 v0 = acc[ai][bj][m][0], v1 = acc[ai][bj][m][1];
                        v4u w; w.x = cvt_pk_bf16(v0[0], v0[1]); w.y = cvt_pk_bf16(v0[2], v0[3]); w.z = cvt_pk_bf16(v1[0], v1[1]); w.w = cvt_pk_bf16(v1[2], v1[3]);
                        *(v4u*)(dst + (size_t)row * RW + half * 256 + bj * 128 + 32 * wc + 8 * fq) = w;
                    }
                }
        } else {
#pragma unroll
            for (int ai = 0; ai < 2; ++ai)
#pragma unroll
                for (int m = 0; m < 4; ++m) {
                    const int row = row0 + ai * 128 + m * 16;
#pragma unroll
                    for (int bj = 0; bj < 2; ++bj) {
                        const int cu = half * 256 + bj * 128 + 32 * wc + 8 * fq, g = cu >> 4, ci0 = cu & 15;
                        const f32x4 v0 = acc[ai][bj][m][0], v1 = acc[ai][bj][m][1];
                        v4u w; w.x = cvt_pk_bf16(v0[0], v0[1]); w.y = cvt_pk_bf16(v0[2], v0[3]); w.z = cvt_pk_bf16(v1[0], v1[1]); w.w = cvt_pk_bf16(v1[2], v1[3]);
                        st16_wt(UX + ((size_t)g * (TT / 16) + (row >> 4)) * 512 + (row & 15) * 16 + ci0, w);
                    }
                }
        }
    }
};
struct EpiGlu {
    static constexpr int NDEFER = 0; struct Carry {};
    const bf16* YB; const float* bias; bf16* MIX;
    __device__ __forceinline__ void operator()(const f32x4 (&acc)[2][2][4][2], const Unit& u, int wr, int wc, int fr, int fq) const {
        const int row0 = u.pm * 256 + wr * 64 + fr, col0 = u.pn * 256 + wc * 32 + 8 * fq;
#pragma unroll
        for (int bj = 0; bj < 2; ++bj) {
            const int c = col0 + bj * 128;
            const f32x4 b0 = *(const f32x4*)(bias + c), b1 = *(const f32x4*)(bias + c + 4);
#pragma unroll
            for (int ai = 0; ai < 2; ++ai)
#pragma unroll
                for (int m = 0; m < 4; ++m) {
                    const int row = row0 + ai * 128 + m * 16;
                    const v4u yw = *(const v4u*)(YB + ((size_t)(c >> 4) * TT + row) * 16 + (c & 15));
                    const f32x4 g0 = acc[ai][bj][m][0] + b0, g1 = acc[ai][bj][m][1] + b1;
                    const f32x4 y0 = (f32x4){bf_lo(yw.x), bf_hi(yw.x), bf_lo(yw.y), bf_hi(yw.y)} * sigmoid4(g0), y1 = (f32x4){bf_lo(yw.z), bf_hi(yw.z), bf_lo(yw.w), bf_hi(yw.w)} * sigmoid4(g1);
                    v4u w; w.x = cvt_pk_bf16(y0[0], y0[1]); w.y = cvt_pk_bf16(y0[2], y0[3]); w.z = cvt_pk_bf16(y1[0], y1[1]); w.w = cvt_pk_bf16(y1[2], y1[3]);
                    *(v4u*)(MIX + (size_t)row * DM + RW + c) = w;
                }
        }
    }
};
template <bool DRY> struct EpiOutT {
    static constexpr int NDEFER = 0; struct Carry {};
    const bf16* H1; const float* rms1; const float* gmix; bf16* X2B; float* ss1;
    __device__ __forceinline__ void operator()(const f32x4 (&acc)[2][2][4][2], const Unit& u, int wr, int wc, int fr, int fq) const {
        const int row0 = u.pm * 256 + wr * 64 + fr, col0 = u.pn * 256 + wc * 32 + 8 * fq;
        f32x4 gi[2][2];
#pragma unroll
        for (int bj = 0; bj < 2; ++bj)
#pragma unroll
            for (int h = 0; h < 2; ++h) { const f32x4 gq = *(const f32x4*)(gmix + col0 + bj * 128 + 4 * h);
                gi[bj][h] = (f32x4){__builtin_amdgcn_rcpf(gq[0]), __builtin_amdgcn_rcpf(gq[1]), __builtin_amdgcn_rcpf(gq[2]), __builtin_amdgcn_rcpf(gq[3])}; }
#pragma unroll
        for (int ai = 0; ai < 2; ++ai) {
            float sm[4];
#pragma unroll
            for (int m = 0; m < 4; ++m) {
                const int row = row0 + ai * 128 + m * 16; float s = 0.f;
                const float rm = rms1[row];
#pragma unroll
                for (int bj = 0; bj < 2; ++bj) {
                    const size_t off = (size_t)row * DM + col0 + bj * 128;
                    const v4u hw = *(const v4u*)(H1 + off);
                    const f32x4 r0 = (f32x4){bf_lo(hw.x), bf_hi(hw.x), bf_lo(hw.y), bf_hi(hw.y)} * gi[bj][0] * rm, r1 = (f32x4){bf_lo(hw.z), bf_hi(hw.z), bf_lo(hw.w), bf_hi(hw.w)} * gi[bj][1] * rm;
                    const f32x4 v0 = acc[ai][bj][m][0] + r0, v1 = acc[ai][bj][m][1] + r1;
                    v4u w; w.x = cvt_pk_bf16(v0[0], v0[1]); w.y = cvt_pk_bf16(v0[2], v0[3]); w.z = cvt_pk_bf16(v1[0], v1[1]); w.w = cvt_pk_bf16(v1[2], v1[3]);
                    if (!DRY) *(v4u*)(X2B + off) = w; else asm volatile("" :: "v"(w));
                    s += (v0[0] * v0[0] + v0[1] * v0[1]) + (v0[2] * v0[2] + v0[3] * v0[3]) + (v1[0] * v1[0] + v1[1] * v1[1]) + (v1[2] * v1[2] + v1[3] * v1[3]);
                }
                s += __shfl_xor(s, 16); s += __shfl_xor(s, 32);
                sm[m] = s;
            }
            const float sv = fq == 0 ? sm[0] : fq == 1 ? sm[1] : fq == 2 ? sm[2] : sm[3];
            if (!DRY) atomicAdd(ss1 + row0 + ai * 128 + fq * 16, sv); else asm volatile("" :: "v"(sv));
        }
    }
};
__device__ __forceinline__ float dpp_prev(float v) { return __builtin_bit_cast(float, __builtin_amdgcn_mov_dpp(__builtin_bit_cast(int, v), 0x121, 0xf, 0xf, false)); }
__device__ __forceinline__ float dpp_next(float v) { return __builtin_bit_cast(float, __builtin_amdgcn_mov_dpp(__builtin_bit_cast(int, v), 0x12F, 0xf, 0xf, false)); }
__device__ __forceinline__ f32x4 dpp_prev4(f32x4 v) { return (f32x4){dpp_prev(v[0]), dpp_prev(v[1]), dpp_prev(v[2]), dpp_prev(v[3])}; }
__device__ __forceinline__ f32x4 dpp_next4(f32x4 v) { return (f32x4){dpp_next(v[0]), dpp_next(v[1]), dpp_next(v[2]), dpp_next(v[3])}; }
struct EpiUp {
    static constexpr int NDEFER = 2; struct Carry { v4u w[2]; };
    bf16* ACT; bf16* ZB; const float* ss1; const float* cw; const float* cb;
    __device__ __forceinline__ void flush(const Carry& c, int j, const Unit& u, int wr, int wc, int fr, int fq) const {
        bf16* p = ACT + (size_t)(u.pm * 256 + wr * 64 + 4 * fr + 128 + 2 + j) * DFF + u.pn * 128 + wc * 32 + fq * 8;
        __builtin_nontemporal_store(c.w[j], (v4u*)p);
    }
    __device__ __forceinline__ void run(const f32x4 (&acc)[2][2][4][2], const Unit& u, int wr, int wc, int fr, int fq, Carry& carry, bool defer) const {
        const int rowb = u.pm * 256 + wr * 64 + 4 * fr;
        const int ch0 = u.pn * 128 + wc * 32 + fq * 8;
        f32x4 rinv[2];
#pragma unroll
        for (int ai = 0; ai < 2; ++ai) { const f32x4 q = *(const f32x4*)(ss1 + rowb + ai * 128);
            const f32x4 qq = q * (1.0f / DM) + EPS;
            rinv[ai] = (f32x4){__builtin_amdgcn_rsqf(qq[0]), __builtin_amdgcn_rsqf(qq[1]), __builtin_amdgcn_rsqf(qq[2]), __builtin_amdgcn_rsqf(qq[3])}; }
        unsigned pk[2][4][2];
        v2u zs[2][4];
#pragma unroll
        for (int n = 0; n < 2; ++n) {
            const int cch = ch0 + 4 * n;
            const f32x4 w0v = *(const f32x4*)(cw + cch), w1v = *(const f32x4*)(cw + NUP + cch), w2v = *(const f32x4*)(cw + 2 * NUP + cch), bv = *(const f32x4*)(cb + cch);
            const f32x4 w0g = *(const f32x4*)(cw + DFF + cch), w1g = *(const f32x4*)(cw + NUP + DFF + cch), w2g = *(const f32x4*)(cw + 2 * NUP + DFF + cch), bg = *(const f32x4*)(cb + DFF + cch);
#pragma unroll
            for (int ai = 0; ai < 2; ++ai) {
                f32x4 zv[4], zg[4];
#pragma unroll
                for (int m = 0; m < 4; ++m) { zv[m] = acc[ai][0][m][n] * rinv[ai][m]; zg[m] = acc[ai][1][m][n] * rinv[ai][m]; }
                const f32x4 pzv = dpp_prev4(zv[3]), nzv = dpp_next4(zv[0]), pzg = dpp_prev4(zg[3]), nzg = dpp_next4(zg[0]);
#pragma unroll
                for (int m = 0; m < 4; ++m) {
                    const f32x4 prv = m > 0 ? zv[m > 0 ? m - 1 : 0] : pzv, nxv = m < 3 ? zv[m < 3 ? m + 1 : 3] : nzv;
                    const f32x4 prg = m > 0 ? zg[m > 0 ? m - 1 : 0] : pzg, nxg = m < 3 ? zg[m < 3 ? m + 1 : 3] : nzg;
                    const f32x4 cv = w0v * prv + (w1v * zv[m] + (w2v * nxv + bv));
                    const f32x4 cg = w0g * prg + (w1g * zg[m] + (w2g * nxg + bg));
                    const f32x4 av = gelu_mul4(cg, cv);
                    const unsigned p0 = cvt_pk_bf16(av[0], av[1]), p1 = cvt_pk_bf16(av[2], av[3]);
                    if (n == 0) { pk[ai][m][0] = p0; pk[ai][m][1] = p1; }
                    else { v4u w; w.x = pk[ai][m][0]; w.y = pk[ai][m][1]; w.z = p0; w.w = p1;
                        if (ai == 1 && m >= 2) carry.w[m - 2] = w;
                        if (ai == 0 || m < 2 || !defer) __builtin_nontemporal_store(w, (v4u*)(ACT + (size_t)(rowb + ai * 128 + m) * DFF + ch0)); }
                }
                if (fr == 0 || fr == 15) {
                    const int blk = u.pm * 4 + ai * 2 + wr;
                    bf16* zrow = ZB + ((size_t)blk * 4 + (fr == 0 ? 0 : 2)) * NUP;
                    const int m0 = fr == 0 ? 0 : 2;
                    v2u a0, a1, g0, g1;
                    if (fr == 0) { a0 = (v2u){cvt_pk_bf16(zv[0][0], zv[0][1]), cvt_pk_bf16(zv[0][2], zv[0][3])}; a1 = (v2u){cvt_pk_bf16(zv[1][0], zv[1][1]), cvt_pk_bf16(zv[1][2], zv[1][3])};
                                   g0 = (v2u){cvt_pk_bf16(zg[0][0], zg[0][1]), cvt_pk_bf16(zg[0][2], zg[0][3])}; g1 = (v2u){cvt_pk_bf16(zg[1][0], zg[1][1]), cvt_pk_bf16(zg[1][2], zg[1][3])}; }
                    else { a0 = (v2u){cvt_pk_bf16(zv[2][0], zv[2][1]), cvt_pk_bf16(zv[2][2], zv[2][3])}; a1 = (v2u){cvt_pk_bf16(zv[3][0], zv[3][1]), cvt_pk_bf16(zv[3][2], zv[3][3])};
                           g0 = (v2u){cvt_pk_bf16(zg[2][0], zg[2][1]), cvt_pk_bf16(zg[2][2], zg[2][3])}; g1 = (v2u){cvt_pk_bf16(zg[3][0], zg[3][1]), cvt_pk_bf16(zg[3][2], zg[3][3])}; }
                    (void)m0;
                    if (n == 0) { zs[ai][0] = a0; zs[ai][1] = g0; zs[ai][2] = a1; zs[ai][3] = g1; }
                    else { *(v4u*)(zrow + ch0) = (v4u){zs[ai][0].x, zs[ai][0].y, a0.x, a0.y}; *(v4u*)(zrow + DFF + ch0) = (v4u){zs[ai][1].x, zs[ai][1].y, g0.x, g0.y};
                           *(v4u*)(zrow + NUP + ch0) = (v4u){zs[ai][2].x, zs[ai][2].y, a1.x, a1.y}; *(v4u*)(zrow + NUP + DFF + ch0) = (v4u){zs[ai][3].x, zs[ai][3].y, g1.x, g1.y}; }
                }
            }
        }
    }
};
struct EpiDownNorm {
    static constexpr int NDEFER = 0; struct Carry {};
    float* X; const bf16* X2B; float* ss2; unsigned* cnt; const float* gain;
    __device__ __forceinline__ void operator()(f32x4 (&acc)[2][2][4][2], const Unit& u, int wr, int wc, int fr, int fq) const {
        const int row0 = u.pm * 256 + wr * 64 + fr, col0 = u.pn * 256 + wc * 32 + 8 * fq;
#pragma unroll
        for (int ai = 0; ai < 2; ++ai) {
            float sm[4];
#pragma unroll
            for (int m = 0; m < 4; ++m) {
                const int row = row0 + ai * 128 + m * 16; float s = 0.f;
#pragma unroll
                for (int bj = 0; bj < 2; ++bj) {
                    const v4u rw = *(const v4u*)(X2B + (size_t)row * DM + col0 + bj * 128);
                    const f32x4 r0 = (f32x4){bf_lo(rw.x), bf_hi(rw.x), bf_lo(rw.y), bf_hi(rw.y)}, r1 = (f32x4){bf_lo(rw.z), bf_hi(rw.z), bf_lo(rw.w), bf_hi(rw.w)};
                    const f32x4 v0 = acc[ai][bj][m][0] + r0, v1 = acc[ai][bj][m][1] + r1;
                    acc[ai][bj][m][0] = v0; acc[ai][bj][m][1] = v1;
                    s += (v0[0] * v0[0] + v0[1] * v0[1]) + (v0[2] * v0[2] + v0[3] * v0[3]) + (v1[0] * v1[0] + v1[1] * v1[1]) + (v1[2] * v1[2] + v1[3] * v1[3]);
                }
                s += __shfl_xor(s, 16); s += __shfl_xor(s, 32);
                sm[m] = s;
            }
            const float sv = fq == 0 ? sm[0] : fq == 1 ? sm[1] : fq == 2 ? sm[2] : sm[3];
            atomicAdd(ss2 + row0 + ai * 128 + fq * 16, sv);
        }
        asm volatile("s_waitcnt vmcnt(0)" ::: "memory");
        unsigned* pc = cnt + 64 * u.pm;
        if ((threadIdx.x & 63) == 0) __hip_atomic_fetch_add(pc, 1u, __ATOMIC_RELAXED, __HIP_MEMORY_SCOPE_AGENT);
        f32x4 gv[2][2];
#pragma unroll
        for (int bj = 0; bj < 2; ++bj) { gv[bj][0] = *(const f32x4*)(gain + col0 + bj * 128); gv[bj][1] = *(const f32x4*)(gain + col0 + bj * 128 + 4); }
        for (unsigned sp = 0; sp < (1u << 22); ++sp) {
            if ((unsigned)__builtin_amdgcn_readfirstlane((int)__hip_atomic_load(pc, __ATOMIC_RELAXED, __HIP_MEMORY_SCOPE_AGENT)) >= 32u) break;
            __builtin_amdgcn_s_sleep(2);
        }
#pragma unroll
        for (int ai = 0; ai < 2; ++ai)
#pragma unroll
            for (int m = 0; m < 4; ++m) {
                const int row = row0 + ai * 128 + m * 16;
                const float ssv = __hip_atomic_load(ss2 + row, __ATOMIC_RELAXED, __HIP_MEMORY_SCOPE_AGENT);
                const float rinv = 1.0f / sqrtf(ssv * (1.0f / DM) + EPS);
#pragma unroll
                for (int bj = 0; bj < 2; ++bj) {
                    float* op = X + (size_t)row * DM + col0 + bj * 128;
                    *(f32x4*)op = acc[ai][bj][m][0] * rinv * gv[bj][0]; *(f32x4*)(op + 4) = acc[ai][bj][m][1] * rinv * gv[bj][1];
                }
            }
    }
};

__device__ __forceinline__ void ret_naive(const Args& a, LAS unsigned char* lds, int G) {
    constexpr int LD = 132;
    LAS float* Qs = (LAS float*)lds; LAS float* Ks = Qs + 64 * LD; LAS float* Vs = Ks + 64 * LD; LAS float* Ss = Vs + 64 * LD;
    const bf16* Q = (const bf16*)(a.ws + WS_Q); const bf16* K = (const bf16*)(a.ws + WS_K); const bf16* V = (const bf16*)(a.ws + WS_V); const bf16* Gt = (const bf16*)(a.ws + WS_G);
    bf16* MIX = (bf16*)a.out;
    const int tid = threadIdx.x, lr = tid >> 3, lc = (tid & 7) * 16;
    for (int unit = blockIdx.x; unit < NSEQ * NHEAD * 32; unit += G) {
        const int b = unit >> 7, h = (unit >> 5) & 3, qt = unit & 31;
        const size_t rowbase = (size_t)b * SEQ;
        const float lg2 = log2f(1.0f - exp2f(-5.0f - (float)h));
        __syncthreads();
        { const v4u* src = (const v4u*)(Q + (rowbase + qt * 64 + lr) * RW + h * DH + lc); const v4u w0 = src[0], w1 = src[1]; LAS float* d = Qs + lr * LD + lc;
          d[0] = bf_lo(w0.x); d[1] = bf_hi(w0.x); d[2] = bf_lo(w0.y); d[3] = bf_hi(w0.y); d[4] = bf_lo(w0.z); d[5] = bf_hi(w0.z); d[6] = bf_lo(w0.w); d[7] = bf_hi(w0.w);
          d[8] = bf_lo(w1.x); d[9] = bf_hi(w1.x); d[10] = bf_lo(w1.y); d[11] = bf_hi(w1.y); d[12] = bf_lo(w1.z); d[13] = bf_hi(w1.z); d[14] = bf_lo(w1.w); d[15] = bf_hi(w1.w); }
        float o[16];
#pragma unroll
        for (int j = 0; j < 16; ++j) o[j] = 0.f;
        for (int kt = 0; kt < 32; ++kt) {
            __syncthreads();
            { const v4u* src = (const v4u*)(K + (rowbase + kt * 64 + lr) * RW + h * DH + lc); const v4u w0 = src[0], w1 = src[1]; LAS float* d = Ks + lr * LD + lc;
              d[0] = bf_lo(w0.x); d[1] = bf_hi(w0.x); d[2] = bf_lo(w0.y); d[3] = bf_hi(w0.y); d[4] = bf_lo(w0.z); d[5] = bf_hi(w0.z); d[6] = bf_lo(w0.w); d[7] = bf_hi(w0.w);
              d[8] = bf_lo(w1.x); d[9] = bf_hi(w1.x); d[10] = bf_lo(w1.y); d[11] = bf_hi(w1.y); d[12] = bf_lo(w1.z); d[13] = bf_hi(w1.z); d[14] = bf_lo(w1.w); d[15] = bf_hi(w1.w); }
            { const v4u* src = (const v4u*)(V + (rowbase + kt * 64 + lr) * RW + h * DH + lc); const v4u w0 = src[0], w1 = src[1]; LAS float* d = Vs + lr * LD + lc;
              d[0] = bf_lo(w0.x); d[1] = bf_hi(w0.x); d[2] = bf_lo(w0.y); d[3] = bf_hi(w0.y); d[4] = bf_lo(w0.z); d[5] = bf_hi(w0.z); d[6] = bf_lo(w0.w); d[7] = bf_hi(w0.w);
              d[8] = bf_lo(w1.x); d[9] = bf_hi(w1.x); d[10] = bf_lo(w1.y); d[11] = bf_hi(w1.y); d[12] = bf_lo(w1.z); d[13] = bf_hi(w1.z); d[14] = bf_lo(w1.w); d[15] = bf_hi(w1.w); }
            __syncthreads();
            {
                float s[8];
#pragma unroll
                for (int jj = 0; jj < 8; ++jj) s[jj] = 0.f;
                for (int d4 = 0; d4 < 32; ++d4) {
                    const f32x4 qv = *(const LAS f32x4*)(Qs + lr * LD + d4 * 4);
#pragma unroll
                    for (int jj = 0; jj < 8; ++jj) { const f32x4 kv = *(const LAS f32x4*)(Ks + ((tid & 7) + 8 * jj) * LD + d4 * 4); s[jj] += (qv[0] * kv[0] + qv[1] * kv[1]) + (qv[2] * kv[2] + qv[3] * kv[3]); }
                }
#pragma unroll
                for (int jj = 0; jj < 8; ++jj) { const int m = (tid & 7) + 8 * jj; const int dist = abs((qt * 64 + lr) - (kt * 64 + m)); Ss[lr * 65 + m] = s[jj] * exp2f(lg2 * (float)dist); }
            }
            __syncthreads();
            for (int m = 0; m < 64; ++m) {
                const float sv = Ss[lr * 65 + m];
#pragma unroll
                for (int j4 = 0; j4 < 4; ++j4) { const f32x4 vv = *(const LAS f32x4*)(Vs + m * LD + lc + j4 * 4); o[j4 * 4 + 0] += sv * vv[0]; o[j4 * 4 + 1] += sv * vv[1]; o[j4 * 4 + 2] += sv * vv[2]; o[j4 * 4 + 3] += sv * vv[3]; }
            }
        }
        float ss = 0.f;
#pragma unroll
        for (int j = 0; j < 16; ++j) ss += o[j] * o[j];
        ss += __shfl_xor(ss, 1); ss += __shfl_xor(ss, 2); ss += __shfl_xor(ss, 4);
        const float rn = 1.0f / sqrtf(ss * (1.0f / DH) + EPS);
        const size_t row = rowbase + qt * 64 + lr;
        const v4u* gsrc = (const v4u*)(Gt + row * RW + h * DH + lc); const v4u g0 = gsrc[0], g1 = gsrc[1];
        const float gg[16] = {bf_lo(g0.x), bf_hi(g0.x), bf_lo(g0.y), bf_hi(g0.y), bf_lo(g0.z), bf_hi(g0.z), bf_lo(g0.w), bf_hi(g0.w), bf_lo(g1.x), bf_hi(g1.x), bf_lo(g1.y), bf_hi(g1.y), bf_lo(g1.z), bf_hi(g1.z), bf_lo(g1.w), bf_hi(g1.w)};
        const float* gain = a.in[I_GN] + h * DH + lc;
        unsigned w[8];
#pragma unroll
        for (int j = 0; j < 8; ++j) { const float r0 = gg[2 * j] * sigmoidf_(gg[2 * j]) * gain[2 * j] * o[2 * j] * rn, r1 = gg[2 * j + 1] * sigmoidf_(gg[2 * j + 1]) * gain[2 * j + 1] * o[2 * j + 1] * rn; w[j] = pk2(r0, r1); }
        v4u* dst = (v4u*)(MIX + row * DM + h * DH + lc);
        dst[0] = (v4u){w[0], w[1], w[2], w[3]}; dst[1] = (v4u){w[4], w[5], w[6], w[7]};
    }
}
__device__ __forceinline__ void s5_naive(const Args& a, int wave, int lane, int G) {
    const bf16* UX = (const bf16*)(a.ws + WS_UX);
    float* YF = a.out;
    for (int task = blockIdx.x * NWAVES + wave; task < NSEQ * SG * 2; task += G * NWAVES) {
        const int dir = task & 1, g = (task >> 1) & 31, b = task >> 6;
        const int pidx = (dir * SG + g) * SNS + lane;
        const float lr = fminf(a.in[I_LRE][pidx], -1e-4f), li = a.in[I_LIM][pidx], dt = expf(a.in[I_LDT][dir * SG + g]);
        const float mag = expf(lr * dt); const float ar = mag * cosf(li * dt), ai = mag * sinf(li * dt);
        const float den = lr * lr + li * li, nr = ar - 1.0f, ni = ai;
        const float cr = (nr * lr + ni * li) / den, ci = (ni * lr - nr * li) / den;
        float bbr[16], bbi[16], cre[16], cim[16];
#pragma unroll
        for (int c = 0; c < 16; ++c) { const float br = a.in[I_BRE][(size_t)pidx * 16 + c], bi = a.in[I_BIM][(size_t)pidx * 16 + c]; bbr[c] = cr * br - ci * bi; bbi[c] = cr * bi + ci * br;
            cre[c] = a.in[I_CRE][((size_t)(dir * SG + g) * 16 + c) * SNS + lane]; cim[c] = a.in[I_CIM][((size_t)(dir * SG + g) * 16 + c) * SNS + lane]; }
        float xr = 0.f, xi = 0.f;
        const int cosel = ((lane >> 5) & 1) * 8 + ((lane >> 4) & 1) * 4 + ((lane >> 3) & 1) * 2 + ((lane >> 2) & 1);
        for (int step0 = 0; step0 < SEQ; step0 += 8) {
            v4u ub[8][2];
#pragma unroll
            for (int s8 = 0; s8 < 8; ++s8) {
                const int t = dir ? (SEQ - 1 - (step0 + s8)) : (step0 + s8); const size_t row = (size_t)b * SEQ + t;
                const v4u* up = (const v4u*)(UX + ((size_t)g * (TT / 16) + (row >> 4)) * 512 + (row & 15) * 16);
                ub[s8][0] = up[0]; ub[s8][1] = up[1];
            }
#pragma unroll
            for (int s8 = 0; s8 < 8; ++s8) {
            const int t = dir ? (SEQ - 1 - (step0 + s8)) : (step0 + s8); const size_t row = (size_t)b * SEQ + t;
            const v4u u0 = ub[s8][0], u1 = ub[s8][1];
            const float uu[16] = {bf_lo(u0.x), bf_hi(u0.x), bf_lo(u0.y), bf_hi(u0.y), bf_lo(u0.z), bf_hi(u0.z), bf_lo(u0.w), bf_hi(u0.w), bf_lo(u1.x), bf_hi(u1.x), bf_lo(u1.y), bf_hi(u1.y), bf_lo(u1.z), bf_hi(u1.z), bf_lo(u1.w), bf_hi(u1.w)};
            float bur = 0.f, bui = 0.f;
#pragma unroll
            for (int c = 0; c < 16; ++c) { bur += bbr[c] * uu[c]; bui += bbi[c] * uu[c]; }
            const float nxr = ar * xr - ai * xi + bur, nxi = ar * xi + ai * xr + bui; xr = nxr; xi = nxi;
            float p[16];
#pragma unroll
            for (int c = 0; c < 16; ++c) p[c] = cre[c] * xr - cim[c] * xi;
#pragma unroll
            for (int i = 0; i < 8; ++i) { const bool up_ = (lane & 32) != 0; const float send = up_ ? p[i] : p[i + 8], keep = up_ ? p[i + 8] : p[i]; p[i] = keep + __shfl_xor(send, 32); }
#pragma unroll
            for (int i = 0; i < 4; ++i) { const bool up_ = (lane & 16) != 0; const float send = up_ ? p[i] : p[i + 4], keep = up_ ? p[i + 4] : p[i]; p[i] = keep + __shfl_xor(send, 16); }
#pragma unroll
            for (int i = 0; i < 2; ++i) { const bool up_ = (lane & 8) != 0; const float send = up_ ? p[i] : p[i + 2], keep = up_ ? p[i + 2] : p[i]; p[i] = keep + __shfl_xor(send, 8); }
            { const bool up_ = (lane & 4) != 0; const float send = up_ ? p[0] : p[1], keep = up_ ? p[1] : p[0]; p[0] = keep + __shfl_xor(send, 4); }
            p[0] += __shfl_xor(p[0], 2); p[0] += __shfl_xor(p[0], 1);
            if ((lane & 3) == 0) YF[((size_t)dir * TT + row) * RW + g * 16 + cosel] = p[0];
            }
        }
    }
}
__device__ __forceinline__ void s5_combine(const Args& a, int G) {
    const bf16* UX = (const bf16*)(a.ws + WS_UX); bf16* YB = (bf16*)(a.ws + WS_YB); const float* YF = a.out; const float* Dk = a.in[I_SD];
    for (size_t i = (size_t)blockIdx.x * NTHREADS + threadIdx.x; i < (size_t)TT * (RW / 8); i += (size_t)G * NTHREADS) {
        const size_t row = i >> 6; const int c8 = (int)(i & 63) * 8, g = c8 >> 4, ci0 = c8 & 15;
        const v4u uw = *(const v4u*)(UX + ((size_t)g * (TT / 16) + (row >> 4)) * 512 + (row & 15) * 16 + ci0);
        const float uu[8] = {bf_lo(uw.x), bf_hi(uw.x), bf_lo(uw.y), bf_hi(uw.y), bf_lo(uw.z), bf_hi(uw.z), bf_lo(uw.w), bf_hi(uw.w)};
        const f32x4 f0 = *(const f32x4*)(YF + row * RW + c8), f1 = *(const f32x4*)(YF + row * RW + c8 + 4);
        const f32x4 b0 = *(const f32x4*)(YF + ((size_t)TT + row) * RW + c8), b1 = *(const f32x4*)(YF + ((size_t)TT + row) * RW + c8 + 4);
        float y[8];
#pragma unroll
        for (int j = 0; j < 4; ++j) { y[j] = gelu_tanh(Dk[c8 + j] * uu[j] + f0[j] + b0[j]); y[4 + j] = gelu_tanh(Dk[c8 + 4 + j] * uu[4 + j] + f1[j] + b1[j]); }
        *(v4u*)(YB + row * RW + c8) = (v4u){pk2(y[0], y[1]), pk2(y[2], y[3]), pk2(y[4], y[5]), pk2(y[6], y[7])};
    }
}
__device__ __forceinline__ void ffn_fixup(const Args& a, int G) {
    const bf16* ZB = (const bf16*)(a.ws + WS_ZB); bf16* ACT = (bf16*)(a.ws + WS_ACT); const float* cw = a.in[I_CONVW]; const float* cb = a.in[I_CONVB];
    constexpr int NBLK = TT / 64, CG = DFF / 8;
    const int gt = blockIdx.x * NTHREADS + threadIdx.x, NT = G * NTHREADS;
    const int cg = gt % CG, slot = gt / CG, nslot = NT / CG;
    if (slot >= nslot) return;
    const int c = cg * 8;
    float wv[3][8], wg[3][8], bv[8], bg[8];
#pragma unroll
    for (int t = 0; t < 3; ++t) { const f32x4 x0 = *(const f32x4*)(cw + t * NUP + c), x1 = *(const f32x4*)(cw + t * NUP + c + 4), y0 = *(const f32x4*)(cw + t * NUP + DFF + c), y1 = *(const f32x4*)(cw + t * NUP + DFF + c + 4);
#pragma unroll
        for (int j = 0; j < 4; ++j) { wv[t][j] = x0[j]; wv[t][4 + j] = x1[j]; wg[t][j] = y0[j]; wg[t][4 + j] = y1[j]; } }
    { const f32x4 x0 = *(const f32x4*)(cb + c), x1 = *(const f32x4*)(cb + c + 4), y0 = *(const f32x4*)(cb + DFF + c), y1 = *(const f32x4*)(cb + DFF + c + 4);
#pragma unroll
      for (int j = 0; j < 4; ++j) { bv[j] = x0[j]; bv[4 + j] = x1[j]; bg[j] = y0[j]; bg[4 + j] = y1[j]; } }
    for (int it = slot; it < NBLK * 2; it += nslot) {
        const int blk = it >> 1, e = it & 1;
        const bool seq_first = (blk & 31) == 0, seq_last = (blk & 31) == 31;
        const bf16 *zp, *zc, *zn; bool hp = true, hn = true; int row;
        if (e == 0) { row = blk * 64; zc = ZB + ((size_t)blk * 4 + 0) * NUP; zn = ZB + ((size_t)blk * 4 + 1) * NUP; hp = !seq_first; zp = hp ? ZB + ((size_t)(blk - 1) * 4 + 3) * NUP : zc; }
        else { row = blk * 64 + 63; zc = ZB + ((size_t)blk * 4 + 3) * NUP; zp = ZB + ((size_t)blk * 4 + 2) * NUP; hn = !seq_last; zn = hn ? ZB + ((size_t)(blk + 1) * 4 + 0) * NUP : zc; }
        const v4u pv = *(const v4u*)(zp + c), cv = *(const v4u*)(zc + c), nv = *(const v4u*)(zn + c);
        const v4u pg = *(const v4u*)(zp + DFF + c), cgv = *(const v4u*)(zc + DFF + c), ng = *(const v4u*)(zn + DFF + c);
        const float mp = hp ? 1.f : 0.f, mn = hn ? 1.f : 0.f;
        const unsigned pvw[4] = {pv.x, pv.y, pv.z, pv.w}, cvw[4] = {cv.x, cv.y, cv.z, cv.w}, nvw[4] = {nv.x, nv.y, nv.z, nv.w};
        const unsigned pgw[4] = {pg.x, pg.y, pg.z, pg.w}, cgw[4] = {cgv.x, cgv.y, cgv.z, cgv.w}, ngw[4] = {ng.x, ng.y, ng.z, ng.w};
        unsigned ow[4];
#pragma unroll
        for (int j2 = 0; j2 < 4; ++j2) {
            float r[2];
#pragma unroll
            for (int hlf = 0; hlf < 2; ++hlf) { const int j = 2 * j2 + hlf;
                const float fpv = (hlf ? bf_hi(pvw[j2]) : bf_lo(pvw[j2])) * mp, fcv = hlf ? bf_hi(cvw[j2]) : bf_lo(cvw[j2]), fnv = (hlf ? bf_hi(nvw[j2]) : bf_lo(nvw[j2])) * mn;
                const float fpg = (hlf ? bf_hi(pgw[j2]) : bf_lo(pgw[j2])) * mp, fcg = hlf ? bf_hi(cgw[j2]) : bf_lo(cgw[j2]), fng = (hlf ? bf_hi(ngw[j2]) : bf_lo(ngw[j2])) * mn;
                const float v = wv[0][j] * fpv + wv[1][j] * fcv + wv[2][j] * fnv + bv[j];
                const float gt_ = wg[0][j] * fpg + wg[1][j] * fcg + wg[2][j] * fng + bg[j];
                r[hlf] = gelu_tanh(gt_) * v; }
            ow[j2] = pk2(r[0], r[1]);
        }
        *(v4u*)(ACT + (size_t)row * DFF + c) = (v4u){ow[0], ow[1], ow[2], ow[3]};
    }
}
template <bool DRY> __device__ __forceinline__ void final_norm(const Args& a, int wave, int lane, int G) {
    const GAS f32x4* gn = (const GAS f32x4*)a.in[I_NFIN] + lane;
    f32x4 gv[4];
#pragma unroll
    for (int j = 0; j < 4; ++j) gv[j] = gn[64 * j];
    for (int m = blockIdx.x * NWAVES + wave; m < TT; m += G * NWAVES) {
        GAS f32x4* xr = (GAS f32x4*)(a.out + (size_t)m * DM) + lane;
        f32x4 v[4]; float s = 0.f;
#pragma unroll
        for (int j = 0; j < 4; ++j) { v[j] = xr[64 * j]; s += (v[j].x * v[j].x + v[j].y * v[j].y) + (v[j].z * v[j].z + v[j].w * v[j].w); }
        const float rinv = 1.0f / sqrtf(wave_sum(s) * (1.0f / DM) + EPS);
#pragma unroll
        for (int j = 0; j < 4; ++j) { const f32x4 o = v[j] * rinv * gv[j]; if (!DRY) xr[64 * j] = o; else asm volatile("" :: "v"(o)); }
    }
}


typedef float f32x2v __attribute__((ext_vector_type(2)));
__device__ __forceinline__ void s5_build(const Args& a, LAS unsigned char* lds, int unit) {
    const int g = unit >> 3, part = unit & 7, tid = threadIdx.x;
    LAS f32x2v* apow = (LAS f32x2v*)lds;
    LAS f32x2v* Bb = apow + 2 * 17 * 64;
    LAS f32x2v* Cc = Bb + 2 * 64 * 16;
    LAS float* Kt = (LAS float*)(Cc + 2 * 16 * 64);
    LAS f32x2v* coefs = (LAS f32x2v*)(Kt + 2 * 16 * 16 * 16);
    if (tid < 128) {
        const int dir = tid >> 6, n = tid & 63, pidx = (dir * SG + g) * SNS + n;
        const float lr = fminf(a.in[I_LRE][pidx], -1e-4f), li = a.in[I_LIM][pidx], dt = expf(a.in[I_LDT][dir * SG + g]);
        const float mag = expf(lr * dt); float sn, cs; sincosf(li * dt, &sn, &cs);
        const float ar = mag * cs, ai = mag * sn;
        const float den = lr * lr + li * li, nr = ar - 1.0f, ni = ai;
        coefs[tid] = (f32x2v){(nr * lr + ni * li) / den, (ni * lr - nr * li) / den};
        float pr = 1.0f, pi = 0.0f;
        for (int j = 0; j < 17; ++j) { apow[(dir * 17 + j) * 64 + n] = (f32x2v){pr, pi}; const float qr = pr * ar - pi * ai, qi = pr * ai + pi * ar; pr = qr; pi = qi; }
    }
    __syncthreads();
    for (int idx = tid; idx < 2 * 64 * 16; idx += NTHREADS) {
        const int dir = idx >> 10, n = (idx >> 4) & 63, ci = idx & 15, pidx = (dir * SG + g) * SNS + n;
        const f32x2v cf = coefs[dir * 64 + n];
        const float br = a.in[I_BRE][(size_t)pidx * 16 + ci], bi = a.in[I_BIM][(size_t)pidx * 16 + ci];
        Bb[idx] = (f32x2v){cf.x * br - cf.y * bi, cf.x * bi + cf.y * br};
    }
    for (int idx = tid; idx < 2 * 16 * 64; idx += NTHREADS) {
        const int dir = idx >> 10, co = (idx >> 6) & 15, n = idx & 63; const size_t p = ((size_t)(dir * SG + g) * 16 + co) * SNS + n;
        Cc[idx] = (f32x2v){a.in[I_CRE][p], a.in[I_CIM][p]};
    }
    __syncthreads();
    {
        const int dir = tid >> 8, j = (tid >> 4) & 15, co = tid & 15;
        float acc[16];
#pragma unroll
        for (int ci = 0; ci < 16; ++ci) acc[ci] = 0.f;
        for (int n = 0; n < 64; ++n) {
            const f32x2v c = Cc[(dir * 16 + co) * 64 + n], p = apow[(dir * 17 + j) * 64 + n];
            const float m1r = c.x * p.x - c.y * p.y, m1i = c.x * p.y + c.y * p.x;
#pragma unroll
            for (int ci = 0; ci < 16; ++ci) { const f32x2v b = Bb[(dir * 64 + n) * 16 + ci]; acc[ci] += m1r * b.x - m1i * b.y; }
        }
#pragma unroll
        for (int ci = 0; ci < 16; ++ci) Kt[((dir * 16 + j) * 16 + co) * 16 + ci] = acc[ci];
    }
    __syncthreads();
    bf16* BtY = (bf16*)(a.ws + WS_BTY) + (size_t)g * 256 * 512; bf16* BtE = (bf16*)(a.ws + WS_BTE) + (size_t)g * 256 * 256;
    for (int q = tid; q < 32 * 64; q += NTHREADS) {
        const int rr = q >> 6, ch = q & 63, i = 2 * part + (rr >> 4), co = rr & 15, row = i * 16 + co;
        float v[8];
        if (ch < 32) {
            const int sidx = ch >> 1;
#pragma unroll
            for (int e = 0; e < 8; ++e) { const int ci = (ch & 1) * 8 + e; float x;
                if (sidx < i) x = Kt[((0 * 16 + (i - sidx)) * 16 + co) * 16 + ci];
                else if (sidx > i) x = Kt[((1 * 16 + (sidx - i)) * 16 + co) * 16 + ci];
                else x = Kt[((0 * 16 + 0) * 16 + co) * 16 + ci] + Kt[((1 * 16 + 0) * 16 + co) * 16 + ci] + (co == ci ? a.in[I_SD][g * 16 + co] : 0.f);
                v[e] = x; }
        } else {
            const int jj0 = (ch - 32) * 8, dir = jj0 >> 7, n0 = (jj0 >> 1) & 63, pw = dir == 0 ? i + 1 : 16 - i;
#pragma unroll
            for (int t = 0; t < 4; ++t) { const f32x2v c = Cc[(dir * 16 + co) * 64 + n0 + t], p = apow[(dir * 17 + pw) * 64 + n0 + t];
                v[2 * t] = c.x * p.x - c.y * p.y; v[2 * t + 1] = -(c.x * p.y + c.y * p.x); }
        }
        *(GAS v4u*)(BtY + (size_t)row * 512 + ch * 8) = (v4u){pk2(v[0], v[1]), pk2(v[2], v[3]), pk2(v[4], v[5]), pk2(v[6], v[7])};
    }
    for (int q = tid; q < 32 * 32; q += NTHREADS) {
        const int rr = q >> 5, ch = q & 31, j = 32 * part + rr, dir = j >> 7, n = (j >> 1) & 63, ri = j & 1;
        const int sidx = ch >> 1, pw = dir == 0 ? 15 - sidx : sidx; const f32x2v p = apow[(dir * 17 + pw) * 64 + n];
        float v[8];
#pragma unroll
        for (int e = 0; e < 8; ++e) { const f32x2v b = Bb[(dir * 64 + n) * 16 + (ch & 1) * 8 + e]; v[e] = ri ? (p.x * b.y + p.y * b.x) : (p.x * b.x - p.y * b.y); }
        *(GAS v4u*)(BtE + (size_t)j * 256 + ch * 8) = (v4u){pk2(v[0], v[1]), pk2(v[2], v[3]), pk2(v[4], v[5]), pk2(v[6], v[7])};
    }
    if (part == 0 && tid < 128) { const int dir = tid >> 6, n = tid & 63; ((GAS f32x2v*)(a.ws + WS_A16))[g * 128 + tid] = apow[(dir * 17 + 16) * 64 + n]; }
    __syncthreads();
}
struct S5Order {
    int G, c;
    __device__ __forceinline__ bool next(int i, Unit& u) const { const int L = i * G + c; if (L >= SG * 12) return false; u.pm = L; u.pn = L / 12; return true; }
    __device__ __forceinline__ void a_ready(const Unit&) const {}
    __device__ __forceinline__ void done(const Unit&) const {}
};
struct EpiE {
    static constexpr int NDEFER = 0; struct Carry {};
    bf16* E;
    __device__ __forceinline__ void operator()(const f32x4 (&acc)[2][2][4][2], const Unit& u, int wr, int wc, int fr, int fq) const {
        bf16* rp = E + (size_t)(u.pm * 256 + wr * 64 + fr) * 256 + wc * 32 + 8 * fq;
#pragma unroll
        for (int ai = 0; ai < 2; ++ai) {
#pragma unroll
            for (int m = 0; m < 4; ++m) {
#pragma unroll
                for (int bj = 0; bj < 2; ++bj) { const f32x4 v0 = acc[ai][bj][m][0], v1 = acc[ai][bj][m][1];
                    *(v4u*)(rp + bj * 128) = (v4u){cvt_pk_bf16(v0[0], v0[1]), cvt_pk_bf16(v0[2], v0[3]), cvt_pk_bf16(v1[0], v1[1]), cvt_pk_bf16(v1[2], v1[3])}; }
                rp += 16 * 256; asm volatile("" : "+v"(rp));
            }
            rp += 64 * 256; asm volatile("" : "+v"(rp));
        }
    }
};
struct EpiY {
    static constexpr int NDEFER = 0; struct Carry {};
    bf16* YB;
    __device__ __forceinline__ void operator()(const f32x4 (&acc)[2][2][4][2], const Unit& u, int wr, int wc, int fr, int fq) const {
        const int g = u.pn, crow0 = (u.pm - g * 12) * 256 + wr * 64 + fr;
#pragma unroll
        for (int ai = 0; ai < 2; ++ai)
#pragma unroll
            for (int m = 0; m < 4; ++m) {
                const int crow = crow0 + ai * 128 + m * 16;
#pragma unroll
                for (int bj = 0; bj < 2; ++bj) {
                    const int i = 8 * bj + 2 * wc + (fq >> 1);
                    const f32x4 v0 = gelu4(acc[ai][bj][m][0]), v1 = gelu4(acc[ai][bj][m][1]);
                    v4u w; w.x = cvt_pk_bf16(v0[0], v0[1]); w.y = cvt_pk_bf16(v0[2], v0[3]); w.z = cvt_pk_bf16(v1[0], v1[1]); w.w = cvt_pk_bf16(v1[2], v1[3]);
                    *(v4u*)(YB + ((size_t)g * TT + (size_t)crow * 16 + i) * 16 + 8 * (fq & 1)) = w;
                }
            }
    }
};
__device__ __forceinline__ void s5_scan(const Args& a, int wg, int nwg) {
    const bf16* E = (const bf16*)a.out; bf16* UX = (bf16*)(a.ws + WS_UX);
    constexpr int NREC = SG * NSEQ * 128, NC = 3;
    for (int base = wg * NTHREADS + threadIdx.x; base < NREC; base += NC * nwg * NTHREADS) {
        f32x2v a16[NC]; size_t row0[NC]; int col[NC], dirv[NC]; float xr[NC], xi[NC]; bool on[NC];
#pragma unroll
        for (int c = 0; c < NC; ++c) {
            const int idx = base + c * nwg * NTHREADS; on[c] = idx < NREC; const int id = on[c] ? idx : base;
            const int n = id & 63, dir = (id >> 6) & 1, gb = id >> 7, b = gb % NSEQ, g = gb / NSEQ;
            a16[c] = ((const f32x2v*)(a.ws + WS_A16))[g * 128 + dir * 64 + n];
            row0[c] = (size_t)g * (TT / 16) + (size_t)b * 128; col[c] = dir * 128 + 2 * n; dirv[c] = dir; xr[c] = 0.f; xi[c] = 0.f;
        }
        for (int k0 = 0; k0 < 128; k0 += 8) {
            unsigned ew[NC][8];
#pragma unroll
            for (int c = 0; c < NC; ++c)
#pragma unroll
                for (int s8 = 0; s8 < 8; ++s8) { const int k = dirv[c] ? 127 - (k0 + s8) : (k0 + s8); ew[c][s8] = *(const unsigned*)(E + (row0[c] + k) * 256 + col[c]); }
#pragma unroll
            for (int c = 0; c < NC; ++c)
#pragma unroll
                for (int s8 = 0; s8 < 8; ++s8) { const int k = dirv[c] ? 127 - (k0 + s8) : (k0 + s8);
                    if (on[c]) *(unsigned*)(UX + (row0[c] + k) * 512 + 256 + col[c]) = pk2(xr[c], xi[c]);
                    const float nxr = a16[c].x * xr[c] - a16[c].y * xi[c] + bf_lo(ew[c][s8]), nxi = a16[c].x * xi[c] + a16[c].y * xr[c] + bf_hi(ew[c][s8]); xr[c] = nxr; xi[c] = nxi; }
        }
    }
}

typedef float f32x16 __attribute__((ext_vector_type(16)));
typedef short bf16x8v __attribute__((ext_vector_type(8)));
typedef short s16x4v __attribute__((ext_vector_type(4)));
#define MFMA32(a, b, c) __builtin_amdgcn_mfma_f32_32x32x16_bf16((a), (b), (c), 0, 0, 0)
constexpr size_t OUT_R_OFF = 96 * MiB;
constexpr int RT0 = 0, RT1 = 32768, RT2 = 65536, RT3 = 98304;
__device__ __forceinline__ int off_row(int row, int chunk) { return row * 256 + ((chunk ^ (row & 15)) << 4); }
__device__ __forceinline__ int off_tr(int row, int colbyte) { return row * 256 + (colbyte ^ ((row & 3) << 6)); }
__device__ __forceinline__ s16x4v tr_rd(LAS unsigned char* p) { return __builtin_bit_cast(s16x4v, __builtin_amdgcn_ds_read_tr16_b64_v4i16((LAS s16x4v*)p)); }
__device__ __forceinline__ unsigned cvtpk(float lo, float hi) { typedef float f2 __attribute__((ext_vector_type(2))); typedef __bf16 b2 __attribute__((ext_vector_type(2))); f2 v = {lo, hi}; b2 b = __builtin_convertvector(v, b2); return __builtin_bit_cast(unsigned, b); }
__device__ __forceinline__ v4u scale8(v4u w, float sc) {
    return (v4u){cvtpk(bf_lo(w.x) * sc, bf_hi(w.x) * sc), cvtpk(bf_lo(w.y) * sc, bf_hi(w.y) * sc), cvtpk(bf_lo(w.z) * sc, bf_hi(w.z) * sc), cvtpk(bf_lo(w.w) * sc, bf_hi(w.w) * sc)};
}
__device__ __forceinline__ void ret_state(const Args& a, LAS unsigned char* lds, int unit) {
    const int tid = threadIdx.x, lane = tid & 63, w = __builtin_amdgcn_readfirstlane(tid >> 6), r = lane & 31, hh = lane >> 5, g1 = (lane >> 4) & 1, ip = lane & 15;
    const int dir = unit & 1, head = (unit >> 1) & 3, b = unit >> 3;
    const float lg2 = log2f(1.0f - exp2f(-5.0f - (float)head)), gC = exp2f(lg2 * 128.0f);
    const bf16* Kg = (const bf16*)(a.ws + WS_K) + (size_t)b * SEQ * RW + head * DH; const bf16* Vg = (const bf16*)(a.ws + WS_V) + (size_t)b * SEQ * RW + head * DH;
    bf16* Rg = (bf16*)((unsigned char*)a.out + OUT_R_OFF) + (size_t)((b * NHEAD + head) * 16) * 2 * 16384 + (size_t)dir * 16384;
    const int eb = w & 3, dh2 = w >> 2;
    f32x16 acc[2];
#pragma unroll
    for (int i = 0; i < 16; ++i) { acc[0][i] = 0.f; acc[1][i] = 0.f; }
    v4u kreg[4], vreg[4];
    {
        const int n0 = dir ? 15 : 0;
#pragma unroll
        for (int i = 0; i < 4; ++i) { const int q = tid + NTHREADS * i, row = q >> 4, ch = q & 15; kreg[i] = *(const v4u*)(Kg + (size_t)(n0 * 128 + row) * RW + ch * 8); vreg[i] = *(const v4u*)(Vg + (size_t)(n0 * 128 + row) * RW + ch * 8); }
    }
    for (int step = 0; step < 16; ++step) {
        const int n = dir ? 15 - step : step;
#pragma unroll
        for (int i = 0; i < 4; ++i) { const int q = tid + NTHREADS * i, row = q >> 4, ch = q & 15;
            const float sc = exp2f(lg2 * (float)(dir ? row : 127 - row));
            *(LAS v4u*)(lds + RT0 + off_tr(row, ch * 16)) = scale8(kreg[i], sc);
            *(LAS v4u*)(lds + RT1 + off_tr(row, ch * 16)) = vreg[i]; }
        if (step < 15) { const int nn = dir ? n - 1 : n + 1;
#pragma unroll
            for (int i = 0; i < 4; ++i) { const int q = tid + NTHREADS * i, row = q >> 4, ch = q & 15; kreg[i] = *(const v4u*)(Kg + (size_t)(nn * 128 + row) * RW + ch * 8); vreg[i] = *(const v4u*)(Vg + (size_t)(nn * 128 + row) * RW + ch * 8); } }
        {
            bf16* Rn = Rg + (size_t)n * 2 * 16384;
#pragma unroll
            for (int dbi = 0; dbi < 2; ++dbi)
#pragma unroll
                for (int i = 0; i < 16; ++i) {
                    const float mine = acc[dbi][i];
                    const float other = __builtin_bit_cast(float, __builtin_amdgcn_update_dpp(0, __builtin_bit_cast(int, mine), 0xB1, 0xf, 0xf, false));
                    if ((lane & 1) == 0) { const int e = 32 * eb + (i & 3) + 8 * (i >> 2) + 4 * hh; *(unsigned*)(Rn + (size_t)e * 128 + 32 * (2 * dh2 + dbi) + r) = cvtpk(mine, other); }
                }
        }
        if (step == 15) break;
#pragma unroll
        for (int i = 0; i < 16; ++i) { acc[0][i] *= gC; acc[1][i] *= gC; }
        __syncthreads();
#pragma unroll
        for (int s = 0; s < 8; ++s) {
            const int m0 = 16 * s + 8 * hh + (ip >> 2);
            const int cbV = (32 * eb + 16 * g1 + 4 * (ip & 3)) * 2;
            const s16x4v v0 = tr_rd(lds + RT1 + off_tr(m0, cbV)), v1 = tr_rd(lds + RT1 + off_tr(m0 + 4, cbV));
            const bf16x8v vb = (bf16x8v){v0[0], v0[1], v0[2], v0[3], v1[0], v1[1], v1[2], v1[3]};
#pragma unroll
            for (int dbi = 0; dbi < 2; ++dbi) {
                const int cbK = (32 * (2 * dh2 + dbi) + 16 * g1 + 4 * (ip & 3)) * 2;
                const s16x4v k0 = tr_rd(lds + RT0 + off_tr(m0, cbK)), k1 = tr_rd(lds + RT0 + off_tr(m0 + 4, cbK));
                const bf16x8v ka = (bf16x8v){k0[0], k0[1], k0[2], k0[3], k1[0], k1[1], k1[2], k1[3]};
                acc[dbi] = MFMA32(vb, ka, acc[dbi]);
            }
        }
        __syncthreads();
    }
    __syncthreads();
}
struct RetPtrs { const bf16 *Qg, *Kg, *Vg, *Rf; };
__device__ __forceinline__ RetPtrs ret_ptrs(const Args& a, int unit) {
    const int n = unit & 15, head = (unit >> 4) & 3, b = unit >> 6;
    const size_t tok0 = (size_t)b * SEQ + (size_t)n * 128;
    RetPtrs p; p.Qg = (const bf16*)(a.ws + WS_Q) + tok0 * RW + head * DH; p.Kg = (const bf16*)(a.ws + WS_K) + tok0 * RW + head * DH; p.Vg = (const bf16*)(a.ws + WS_V) + tok0 * RW + head * DH;
    p.Rf = (const bf16*)((const unsigned char*)a.out + OUT_R_OFF) + (size_t)((b * NHEAD + head) * 16 + n) * 2 * 16384; return p;
}
__device__ __forceinline__ void ret_out_all(const Args& a, LAS unsigned char* lds, int first, int stride, int nunits) {
    const int tid_ = threadIdx.x, lane = tid_ & 63, w = __builtin_amdgcn_readfirstlane(tid_ >> 6), r_ = lane & 31, hh = lane >> 5, g1 = (lane >> 4) & 1, ip_ = lane & 15;
    const int cb = w & 3, half = w >> 2, c_ = 32 * cb + r_;
    if (first >= nunits) return;
    v4u kreg[4], vreg[4], freg[4], breg[4];
#define RET_FETCH(unit_, tid, r) do { const RetPtrs p_ = ret_ptrs(a, (unit_)); \
        _Pragma("unroll") for (int i = 0; i < 4; ++i) { const int q = tid + NTHREADS * i, row = q >> 4, ch = q & 15; \
            kreg[i] = *(const v4u*)(p_.Kg + (size_t)row * RW + ch * 8); vreg[i] = *(const v4u*)(p_.Vg + (size_t)row * RW + ch * 8); \
            freg[i] = *(const v4u*)(p_.Rf + row * 128 + ch * 8); breg[i] = *(const v4u*)(p_.Rf + 16384 + row * 128 + ch * 8); } } while (0)
    RET_FETCH(first, tid_, r_);
    for (int unit = first; unit < nunits; unit += stride) {
        const int n = unit & 15, head = (unit >> 4) & 3, b = unit >> 6;
        const float lg2 = log2f(1.0f - exp2f(-5.0f - (float)head));
        const size_t tok0 = (size_t)b * SEQ + (size_t)n * 128;
        int tid = tid_, r = r_, ip = ip_, c = c_;
        asm volatile("" : "+v"(tid), "+v"(r), "+v"(ip), "+v"(c));
        bf16x8v qf[8];
        { const bf16* Qg = (const bf16*)(a.ws + WS_Q) + tok0 * RW + head * DH;
#pragma unroll
          for (int s = 0; s < 8; ++s) qf[s] = *(const bf16x8v*)(Qg + (size_t)(32 * cb + r) * RW + 16 * s + 8 * hh); }
#pragma unroll
        for (int i = 0; i < 4; ++i) { const int q = tid + NTHREADS * i, row = q >> 4, ch = q & 15;
            *(LAS v4u*)(lds + RT0 + off_row(row, ch)) = kreg[i]; *(LAS v4u*)(lds + RT1 + off_tr(row, ch * 16)) = vreg[i];
            *(LAS v4u*)(lds + RT2 + off_row(row, ch)) = freg[i]; *(LAS v4u*)(lds + RT3 + off_row(row, ch)) = breg[i]; }
        __syncthreads();
        f32x16 O[4];
        {
            const int Rt = half ? RT3 : RT2;
            const float sc = exp2f(lg2 * (float)(half ? 128 - c : c + 1));
#pragma unroll
            for (int eb = 0; eb < 4; ++eb) {
#pragma unroll
                for (int i = 0; i < 16; ++i) O[eb][i] = 0.f;
#pragma unroll
                for (int s = 0; s < 8; ++s) { const bf16x8v rf = *(const LAS bf16x8v*)(lds + Rt + off_row(32 * eb + r, 2 * s + hh)); O[eb] = MFMA32(rf, qf[s], O[eb]); }
#pragma unroll
                for (int i = 0; i < 16; ++i) O[eb][i] *= sc;
            }
        }
        bf16x8v pb[2][2];
#pragma unroll
        for (int mbi = 0; mbi < 2; ++mbi) {
            const int mb = 2 * half + mbi;
            f32x16 S;
#pragma unroll
            for (int i = 0; i < 16; ++i) S[i] = 0.f;
#pragma unroll
            for (int s = 0; s < 8; ++s) { const bf16x8v kf = *(const LAS bf16x8v*)(lds + RT0 + off_row(32 * mb + r, 2 * s + hh)); S = MFMA32(kf, qf[s], S); }
#pragma unroll
            for (int i = 0; i < 16; ++i) { const int m = 32 * mb + (i & 3) + 8 * (i >> 2) + 4 * hh; const int dist = c > m ? c - m : m - c; S[i] *= exp2f(lg2 * (float)dist); }
#pragma unroll
            for (int s2 = 0; s2 < 2; ++s2) {
                const v4u p = (v4u){cvtpk(S[8 * s2], S[8 * s2 + 1]), cvtpk(S[8 * s2 + 2], S[8 * s2 + 3]), cvtpk(S[8 * s2 + 4], S[8 * s2 + 5]), cvtpk(S[8 * s2 + 6], S[8 * s2 + 7])};
                pb[mbi][s2] = __builtin_bit_cast(bf16x8v, p);
            }
        }
#pragma unroll
        for (int eb = 0; eb < 4; ++eb) {
            const int cbV = (32 * eb + 16 * g1 + 4 * (ip & 3)) * 2;
#pragma unroll
            for (int mbi = 0; mbi < 2; ++mbi)
#pragma unroll
                for (int s2 = 0; s2 < 2; ++s2) {
                    const int t0 = 32 * (2 * half + mbi) + 16 * s2 + 4 * hh + (ip >> 2);
                    const s16x4v v0 = tr_rd(lds + RT1 + off_tr(t0, cbV)), v1 = tr_rd(lds + RT1 + off_tr(t0 + 8, cbV));
                    const bf16x8v va = (bf16x8v){v0[0], v0[1], v0[2], v0[3], v1[0], v1[1], v1[2], v1[3]};
                    O[eb] = MFMA32(va, pb[mbi][s2], O[eb]);
                }
        }
        __syncthreads();
        if (unit + stride < nunits) RET_FETCH(unit + stride, tid, r);
        LAS float* Xch = (LAS float*)lds;
        if (half == 1) {
#pragma unroll
            for (int eb = 0; eb < 4; ++eb)
#pragma unroll
                for (int i = 0; i < 16; ++i) Xch[((w & 3) * 64 + eb * 16 + i) * 64 + lane] = O[eb][i];
        }
        __syncthreads();
        LAS unsigned char* Ob = lds + 65536;
        LAS float* rnv = (LAS float*)(lds + 65536 + 32768);
        if (half == 0) {
            float ss = 0.f;
#pragma unroll
            for (int eb = 0; eb < 4; ++eb)
#pragma unroll
                for (int i = 0; i < 16; ++i) { O[eb][i] += Xch[(w * 64 + eb * 16 + i) * 64 + lane]; ss += O[eb][i] * O[eb][i]; }
            ss += __shfl_xor(ss, 32);
            if (hh == 0) rnv[c] = 1.0f / sqrtf(ss * (1.0f / DH) + EPS);
#pragma unroll
            for (int eb = 0; eb < 4; ++eb)
#pragma unroll
                for (int rg = 0; rg < 4; ++rg) { const int e0 = 32 * eb + 8 * rg + 4 * hh;
                    *(LAS v2u*)(Ob + c * 256 + ((((e0 >> 3) ^ (c & 15)) << 4) | ((e0 & 4) << 1))) = (v2u){cvtpk(O[eb][4 * rg], O[eb][4 * rg + 1]), cvtpk(O[eb][4 * rg + 2], O[eb][4 * rg + 3])}; }
        }
        __syncthreads();
        {
            const float* gn = a.in[I_GN] + head * DH;
#pragma unroll
            for (int it = 0; it < 4; ++it) { const int q = tid + NTHREADS * it, row = q >> 4, ch = q & 15;
                const v4u ow = *(const LAS v4u*)(Ob + row * 256 + ((ch ^ (row & 15)) << 4));
                const v4u gw = *(const v4u*)((const bf16*)(a.ws + WS_G) + (tok0 + row) * RW + head * DH + ch * 8);
                const f32x4 ga = *(const f32x4*)(gn + ch * 8), gb = *(const f32x4*)(gn + ch * 8 + 4);
                const float rn = rnv[row];
                const float g0 = bf_lo(gw.x), g1_ = bf_hi(gw.x), g2 = bf_lo(gw.y), g3 = bf_hi(gw.y), g4 = bf_lo(gw.z), g5 = bf_hi(gw.z), g6 = bf_lo(gw.w), g7 = bf_hi(gw.w);
                v4u o;
                o.x = cvtpk(g0 * sigmoidf_(g0) * ga[0] * rn * bf_lo(ow.x), g1_ * sigmoidf_(g1_) * ga[1] * rn * bf_hi(ow.x));
                o.y = cvtpk(g2 * sigmoidf_(g2) * ga[2] * rn * bf_lo(ow.y), g3 * sigmoidf_(g3) * ga[3] * rn * bf_hi(ow.y));
                o.z = cvtpk(g4 * sigmoidf_(g4) * gb[0] * rn * bf_lo(ow.z), g5 * sigmoidf_(g5) * gb[1] * rn * bf_hi(ow.z));
                o.w = cvtpk(g6 * sigmoidf_(g6) * gb[2] * rn * bf_lo(ow.w), g7 * sigmoidf_(g7) * gb[3] * rn * bf_hi(ow.w));
                *(v4u*)((bf16*)a.out + (tok0 + row) * DM + head * DH + ch * 8) = o; }
        }
        __syncthreads();
    }
#undef RET_FETCH
}

__global__ void __launch_bounds__(NTHREADS, 2) hybrid_fwd(Args args) {
    extern __shared__ __attribute__((aligned(16))) unsigned char lds[];
    LAS unsigned char* L = (LAS unsigned char*)lds;
    volatile LAS unsigned* MISC = (volatile LAS unsigned*)(L + MISC_OFF);
    const int tid = threadIdx.x, lane = tid & 63, wave = __builtin_amdgcn_readfirstlane(tid >> 6);
    const int G = gridDim.x; const int bx = blockIdx.x; const int vcu = (G % 8 == 0) ? (bx % 8) * (G / 8) + bx / 8 : bx;
    unsigned char* ws = args.ws;
    for (int u = tid; u < (LDS_BYTES - LDSCTL_OFF) / 4; u += NTHREADS) ((LAS unsigned*)(L + LDSCTL_OFF))[u] = 0u;
    __syncthreads();
    XcdBarrier bar; bar.bar = (unsigned*)(ws + WS_CTL) + CW_BAR; bar.x = 0; bar.st = nullptr;
    if (N_LAUNCHES == 1) bar = xcd_barrier_post((unsigned*)(ws + WS_CTL) + CW_BAR, MISC + 8);
    const int lo = args.ph_lo, hi = args.ph_hi;
#ifndef MK_PHASE_MASK
#define MK_PHASE_MASK 0x3ff
#endif
#define IN(k) (((MK_PHASE_MASK >> (k)) & 1) && lo <= (k) && (k) < hi)
#define SEAM(k) do { if (IN(k) && IN((k) + 1)) xcd_barrier(bar); } while (0)

#ifndef MK_REPEAT_MASK
#define MK_REPEAT_MASK 0
#endif
#define NREP(k) (((MK_REPEAT_MASK >> (k)) & 1) ? 2 : 1)
#define RUN(k, BODY) do { if (IN(k)) { if (NREP(k) == 2) { BODY; xcd_barrier(bar); } BODY; } } while (0)
#define BODY0 { p0_prologue(args, L, wave, lane, vcu, G); }
#define BODY1 { pg8::Gemm g{(const bf16*)(ws + WS_H1), (const bf16*)(ws + WS_WIN), TT, INW, DM, DM, DM, true}; \
        EpiIn E{(bf16*)(ws + WS_Q), (bf16*)(ws + WS_K), (bf16*)(ws + WS_V), (bf16*)(ws + WS_G), (bf16*)(ws + WS_UX), (const float*)(ws + WS_ROT), (const float*)(ws + WS_ROT) + SEQ * 64}; \
        if (G == 256) { P1Order S; S.init(G, bx, (unsigned*)(ws + WS_CTL) + CW_UXRDY); pg8::gemm_phase<EpiIn, P1Order, true>(L, g, S, E); \
            if (bx >= 128) { pg8::Gemm g2{(const bf16*)(ws + WS_UX), (const bf16*)(ws + WS_BTE), SG * (TT / 16), 256, 256, 512, 256}; S5ESubOrder S2{128, bx - 128, (const unsigned*)(ws + WS_CTL) + CW_UXRDY}; EpiE E2{(bf16*)args.out}; \
                pg8::gemm_phase<EpiE, S5ESubOrder, true>(L, g2, S2, E2); } } \
        else { pg8::StaticOrder S; S.init(TT, INW, G, bx, MK_WGM1); pg8::gemm_phase<EpiIn, pg8::StaticOrder, true>(L, g, S, E); } }
#define BODY2 { if (G != 256) { \
        pg8::Gemm g{(const bf16*)(ws + WS_UX), (const bf16*)(ws + WS_BTE), SG * (TT / 16), 256, 256, 512, 256}; S5Order S{G, bx}; EpiE E{(bf16*)args.out}; \
        pg8::gemm_phase<EpiE, S5Order, true>(L, g, S, E); } }
#define BODY3 { if (G >= 256) { if (bx < NSEQ * NHEAD * 2) ret_state(args, L, bx); else s5_scan(args, bx - NSEQ * NHEAD * 2, G - NSEQ * NHEAD * 2); } \
        else { for (int un = bx; un < NSEQ * NHEAD * 2; un += G) ret_state(args, L, un); s5_scan(args, bx, G); } }
#define S5Y_ALL { pg8::Gemm g{(const bf16*)(ws + WS_UX), (const bf16*)(ws + WS_BTY), SG * (TT / 16), 256, 512, 512, 512}; S5Order S{G, bx}; EpiY E{(bf16*)(ws + WS_YB)}; \
        pg8::gemm_phase<EpiY, S5Order, true>(L, g, S, E); }
#define BODY4 { if (G == 256) { if (bx < 128) { S5Y_ALL ret_out_all(args, L, bx, 128, 640); }        \
                                else { ret_out_all(args, L, 640 + (bx - 128), 128, NSEQ * NHEAD * 16); S5Y_ALL } } \
        else { ret_out_all(args, L, bx, G, NSEQ * NHEAD * 16); S5Y_ALL } }
#define BODY5 { pg8::Gemm g{(const bf16*)(ws + WS_YB), (const bf16*)(ws + WS_WGLU), TT, RW, RW, RW, RW, true, true}; pg8::StaticOrder S; S.init(TT, RW, G, bx, MK_WGM5); \
        EpiGlu E{(const bf16*)(ws + WS_YB), args.in[I_GLUB], (bf16*)args.out}; pg8::gemm_phase<EpiGlu, pg8::StaticOrder, true>(L, g, S, E); }
#define BODY6(DRY) { pg8::Gemm g{(const bf16*)args.out, (const bf16*)(ws + WS_WOUT), TT, DM, DM, DM, DM, true}; pg8::StaticOrder S; S.init(TT, DM, G, bx, MK_WGM6); \
        EpiOutT<DRY> E{(const bf16*)(ws + WS_H1), (const float*)(ws + WS_RMS1), args.in[I_NMIX], (bf16*)(ws + WS_X2B), (float*)(ws + WS_SS1)}; pg8::gemm_phase<EpiOutT<DRY>, pg8::StaticOrder, true>(L, g, S, E); }
#define BODY7 { pg8::Gemm g{(const bf16*)(ws + WS_X2B), (const bf16*)(ws + WS_WUP), TT, NUP, DM, DM, DM, true}; pg8::StaticOrder S; S.init(TT, NUP, G, bx, MK_WGM7); \
        EpiUp E{(bf16*)(ws + WS_ACT), (bf16*)(ws + WS_ZB), (const float*)(ws + WS_SS1), args.in[I_CONVW], args.in[I_CONVB]}; pg8::gemm_phase<EpiUp, pg8::StaticOrder, true, true>(L, g, S, E); }
#define BODY8 { ffn_fixup(args, G); }
#define BODY9 { pg8::Gemm g{(const bf16*)(ws + WS_ACT), (const bf16*)(ws + WS_WDN), TT, DM, DFF, DFF, DFF, true}; pg8::StaticOrder S; S.init(TT, DM, G, bx, MK_WGM9); \
        EpiDownNorm E{args.out, (const bf16*)(ws + WS_X2B), (float*)(ws + WS_SS2), (unsigned*)(ws + WS_CTL) + CW_PANEL, args.in[I_NFIN]}; pg8::gemm_phase<EpiDownNorm, pg8::StaticOrder, true>(L, g, S, E); }
    RUN(0, BODY0); SEAM(0);
    RUN(1, BODY1); SEAM(1);
    RUN(2, BODY2); if (G != 256) SEAM(2);
    RUN(3, BODY3); SEAM(3);
    RUN(4, BODY4); SEAM(4);
    RUN(5, BODY5); SEAM(5);
    if (IN(6)) { if (NREP(6) == 2) { BODY6(true); xcd_barrier(bar); } BODY6(false); } SEAM(6);
    RUN(7, BODY7); SEAM(7);
    RUN(8, BODY8); SEAM(8);
    if (IN(9)) BODY9;
#undef IN
#undef SEAM
}

extern "C" void kernel_launch(void* const* d_in, const int* in_sizes, int n_in, void* d_out, int out_size, void* d_ws, size_t ws_size, hipStream_t stream) {
    static int grid = 0;
    if (grid == 0) {
        if (n_in != 22 || out_size != TT * DM || ws_size < WS_END) { fprintf(stderr, "kernel_launch: unexpected shapes (n_in %d out %d ws %zu, need ws >= %zu)\n", n_in, out_size, ws_size, (size_t)WS_END); grid = -1; return; }
        int dev = 0, cus = 0, per_cu = 0;
        if (hipGetDevice(&dev) != hipSuccess || hipDeviceGetAttribute(&cus, hipDeviceAttributeMultiprocessorCount, dev) != hipSuccess) { grid = -1; return; }
        if (hipFuncSetAttribute((const void*)hybrid_fwd, hipFuncAttributeMaxDynamicSharedMemorySize, LDS_BYTES) != hipSuccess) { fprintf(stderr, "kernel_launch: hipFuncSetAttribute failed\n"); grid = -1; return; }
        if (hipOccupancyMaxActiveBlocksPerMultiprocessor(&per_cu, (const void*)hybrid_fwd, NTHREADS, LDS_BYTES) != hipSuccess || per_cu < 1)
            fprintf(stderr, "kernel_launch: occupancy query reports %d workgroups per CU\n", per_cu);
        (void)hipGetLastError();
        grid = cus;
    }
    if (grid < 0) return;
    if (hipMemsetAsync((char*)d_ws + WS_CTL, 0, CTL_ZERO_BYTES, stream) != hipSuccess) { fprintf(stderr, "kernel_launch: memset failed\n"); return; }
    Args a{};
    for (int i = 0; i < 22; ++i) a.in[i] = (const float*)d_in[i];
    a.out = (float*)d_out; a.ws = (unsigned char*)d_ws;
    if (N_LAUNCHES == 1) { a.ph_lo = 0; a.ph_hi = N_PHASES; hipLaunchKernelGGL(hybrid_fwd, dim3(grid), dim3(NTHREADS), LDS_BYTES, stream, a); }
    else for (int p = 0; p < N_PHASES; ++p) { a.ph_lo = p; a.ph_hi = p + 1; hipLaunchKernelGGL(hybrid_fwd, dim3(grid), dim3(NTHREADS), LDS_BYTES, stream, a); }
}
```

```cpp
#include <hip/hip_runtime.h>
#include <cstdio>
#include <cstdint>

#ifndef MK_WGM1
#define MK_WGM1 4
#endif
#ifndef MK_WGM5
#define MK_WGM5 4
#endif
#ifndef MK_WGM6
#define MK_WGM6 2
#endif
#ifndef MK_WGM7
#define MK_WGM7 4
#endif
#ifndef MK_WGM9
#define MK_WGM9 4
#endif
#ifndef MK_N_LAUNCHES
#define MK_N_LAUNCHES 1
#endif

namespace pg8 {
#define PG8_LAS __attribute__((address_space(3)))
typedef unsigned short bf16_t;
typedef short bf16x8 __attribute__((ext_vector_type(8)));
typedef float f32x4 __attribute__((ext_vector_type(4)));
typedef unsigned u32x4 __attribute__((ext_vector_type(4)));
typedef unsigned u32x2 __attribute__((ext_vector_type(2)));
constexpr int BM = 256, BK = 64, HALF = 128, HTB = HALF * BK * 2, STAGE_BYTES = 8 * HTB, NXCD = 8;

__host__ __device__ __forceinline__ int lds_byte(int r, int c) { const int st = (r >> 4) * 2 + (c >> 5), rr = r & 15, cc = c & 31, ob = rr * 64 + cc * 2; return st * 1024 + (ob ^ (((ob >> 9) & 1) << 5)); }
__host__ __device__ __forceinline__ void stage_rc(int b, int& R, int& C) { const int st = b / 1024, sb = b % 1024, swz = sb ^ (((sb >> 9) & 1) << 5); R = (st >> 1) * 16 + swz / 64; C = (st & 1) * 32 + (swz % 64) / 2; }
__host__ __device__ __forceinline__ int perm32(int rho) { const int n = rho >> 4, i = rho & 15; return 8 * (i >> 2) + 4 * n + (i & 3); }

struct Unit { int pm, pn; };
struct Gemm { const bf16_t* A; const bf16_t* Bt; int M, N, K, lda, ldb; bool bimg = false; bool a_gm = false; };

struct StaticOrder {
    int nM, nN, nwg, G, c, WGM;
    __host__ __device__ void init(int M, int N, int G_, int c_, int wgm = 4) { nM = M / BM; nN = N / BM; nwg = nM * nN; G = G_; c = c_; WGM = wgm; }
    __host__ __device__ void map(int wgid, Unit& u) const {
        { const int q = nwg / NXCD, r = nwg % NXCD, xcd = wgid % NXCD, off = wgid / NXCD; wgid = (xcd < r ? xcd * (q + 1) : r * (q + 1) + (xcd - r) * q) + off; }
        const int nig = WGM * nN, gid = wgid / nig, fm = gid * WGM, gsz = (nM - fm) < WGM ? (nM - fm) : WGM;
        u.pm = fm + ((wgid % nig) % gsz); u.pn = (wgid % nig) / gsz;
    }
    __host__ __device__ bool next(int i, Unit& u) const {
        const long L = (long)i * G + c; if (L >= nwg) return false;
        map((int)L, u); return true;
    }
    __device__ __forceinline__ void a_ready(const Unit&) const {}
    __device__ __forceinline__ void done(const Unit&) const {}
};

__device__ __forceinline__ unsigned cvt_pk_bf16(float lo, float hi) { unsigned r; asm volatile("v_cvt_pk_bf16_f32 %0, %1, %2" : "=v"(r) : "v"(lo), "v"(hi)); return r; }

template <class Epi, class Sched, bool ALIGN_EPI, bool ROWPERM = false, int A_AUX = 0>
__device__ __forceinline__ void gemm_phase(PG8_LAS unsigned char* lds, const Gemm g, const Sched& S, const Epi& E) {
    const int tid = threadIdx.x, wid = __builtin_amdgcn_readfirstlane(tid >> 6), lane = tid & 63, wr = wid >> 2, wc = wid & 3, fr = lane & 15, fq = lane >> 4;
    const int K = g.K, nt = K / BK;
    unsigned voffA[2], voffB[2];
#pragma unroll
    for (int i = 0; i < 2; ++i) { int R, C; stage_rc(tid * 16 + i * 8192, R, C); const int Rb = (R & ~31) + perm32(R & 31);
        const int Ra = ROWPERM ? ((R >> 6) * 128 + 4 * (R & 15) + ((R >> 4) & 3)) : R;
        voffA[i] = g.a_gm ? (unsigned)(((C >> 4) * g.M + Ra) * 16 + (C & 15)) * 2u : (unsigned)(Ra * g.lda + C) * 2u; voffB[i] = g.bimg ? (unsigned)(tid * 16 + i * 8192) : (unsigned)(Rb * g.ldb + C) * 2u; }
    const size_t kstepB = g.bimg ? (size_t)HTB : (size_t)(BK * 2), kstep = g.a_gm ? (size_t)4 * g.M * 16 * 2 : (size_t)(BK * 2);
    const size_t hstepA0 = g.a_gm ? (size_t)HALF * 16 * 2 : (size_t)HALF * g.lda * 2, hstepB = g.bimg ? (size_t)(g.K / BK) * HTB : (size_t)HALF * g.ldb * 2;
    const size_t tstepA = 2 * hstepA0, tstepB = 2 * hstepB, hstepA = ROWPERM ? hstepA0 / 2 : hstepA0;
    const unsigned ldsw = (unsigned)wid * 1024u;
    const int aoff = lds_byte(wr * 64 + fr, fq * 8), boff = lds_byte(wc * 32 + fr, fq * 8);
#define PG8_SA(b, h) (((b) * 2 + (h)) * HTB)
#define PG8_SB(b, h) ((4 + (b) * 2 + (h)) * HTB)
#define PG8_STAGE(bufoff, gbase, voff) do { _Pragma("unroll") for (int _i = 0; _i < 2; ++_i) \
        __builtin_amdgcn_global_load_lds((const unsigned*)((const char*)(gbase) + (voff)[_i]), (PG8_LAS unsigned*)(lds + (bufoff) + ldsw + _i * 8192), 16, 0, 0); } while (0)
#define PG8_STAGE_A(bufoff, gbase, voff) do { _Pragma("unroll") for (int _i = 0; _i < 2; ++_i) \
        __builtin_amdgcn_global_load_lds((const unsigned*)((const char*)(gbase) + (voff)[_i]), (PG8_LAS unsigned*)(lds + (bufoff) + ldsw + _i * 8192), 16, 0, A_AUX); } while (0)
#define PG8_LDA(dst, b, h) do { _Pragma("unroll") for (int m = 0; m < 4; ++m) _Pragma("unroll") for (int k = 0; k < 2; ++k) dst[m][k] = *(const PG8_LAS bf16x8*)(lds + PG8_SA(b, h) + aoff + m * 2048 + k * 1024); } while (0)
#define PG8_LDB(dst, b, h) do { _Pragma("unroll") for (int n = 0; n < 2; ++n) _Pragma("unroll") for (int k = 0; k < 2; ++k) dst[n][k] = *(const PG8_LAS bf16x8*)(lds + PG8_SB(b, h) + boff + n * 2048 + k * 1024); } while (0)
#define PG8_MMA(ai, bj, At, Bt) do { __builtin_amdgcn_s_setprio(1); _Pragma("unroll") for (int m = 0; m < 4; ++m) _Pragma("unroll") for (int n = 0; n < 2; ++n) _Pragma("unroll") for (int k = 0; k < 2; ++k) \
        acc[ai][bj][m][n] = __builtin_amdgcn_mfma_f32_16x16x32_bf16(Bt[n][k], At[m][k], acc[ai][bj][m][n], 0, 0, 0); __builtin_amdgcn_s_setprio(0); } while (0)
#define PG8_WAIT_V(n) asm volatile("s_waitcnt vmcnt(" #n ")" ::: "memory")
#define PG8_WAIT_L(n) asm volatile("s_waitcnt lgkmcnt(" #n ")" ::: "memory")
#define PG8_BAR __builtin_amdgcn_s_barrier()
#define PG8_SCHED __builtin_amdgcn_sched_barrier(0)
    Unit cur, nxt, prev; int ui = 0;
    if (!S.next(0, cur)) return;
    prev = cur;
    typename Epi::Carry carry;
    f32x4 acc[2][2][4][2];
#pragma unroll
    for (int a = 0; a < 2; ++a)
#pragma unroll
        for (int b = 0; b < 2; ++b)
#pragma unroll
            for (int m = 0; m < 4; ++m)
#pragma unroll
                for (int n = 0; n < 2; ++n) acc[a][b][m][n] = (f32x4){0.f, 0.f, 0.f, 0.f};
    bf16x8 At[4][2], B0[2][2], B1[2][2];
    const char* cA = (const char*)g.A + (size_t)cur.pm * tstepA; const char* cB = (const char*)g.Bt + (size_t)cur.pn * tstepB;
    S.a_ready(cur);
    PG8_STAGE(PG8_SB(0, 0), cB, voffB); PG8_STAGE(PG8_SB(0, 1), cB + hstepB, voffB); PG8_STAGE_A(PG8_SA(0, 0), cA, voffA); PG8_STAGE_A(PG8_SA(0, 1), cA + hstepA, voffA);
    if (wr == 1) PG8_BAR;
    PG8_WAIT_V(2); PG8_BAR;
    PG8_STAGE(PG8_SB(1, 0), cB + kstepB, voffB); PG8_STAGE_A(PG8_SA(1, 0), cA + kstep, voffA); PG8_STAGE(PG8_SB(1, 1), cB + hstepB + kstepB, voffB);
    PG8_WAIT_V(6); PG8_BAR;
    for (;;) {
        const bool has_next = S.next(ui + 1, nxt);
        const char* nA = has_next ? (const char*)g.A + (size_t)nxt.pm * tstepA : cA; const char* nB = has_next ? (const char*)g.Bt + (size_t)nxt.pn * tstepB : cB;
#pragma unroll 1
        for (int t = 0; t < nt; t += 2) {
            const bool last = (t == nt - 2);
            const bool pend = Epi::NDEFER > 0 && t == 0 && ui > 0;
            const char* a1 = cA + (size_t)(t + 1) * kstep;
            const char* a2 = last ? nA : cA + (size_t)(t + 2) * kstep; const char* b2 = last ? nB : cB + (size_t)(t + 2) * kstepB;
            const char* a3 = a2 + kstep; const char* b3 = b2 + kstepB;
            if (last && has_next) S.a_ready(nxt);
            PG8_LDB(B0, 0, 0); PG8_LDB(B1, 0, 1); PG8_SCHED; PG8_LDA(At, 0, 0); PG8_STAGE_A(PG8_SA(1, 1), a1 + hstepA, voffA);
            PG8_WAIT_V(8); PG8_WAIT_L(0); PG8_BAR; PG8_MMA(0, 0, At, B0); PG8_MMA(0, 1, At, B1); PG8_BAR; PG8_SCHED;
            if constexpr (Epi::NDEFER > 0) { if (pend) { int fr_ = fr, fq_ = fq; asm volatile("" : "+v"(fr_), "+v"(fq_)); E.flush(carry, 0, prev, wr, wc, fr_, fq_); } }
            PG8_LDA(At, 0, 1); PG8_STAGE(PG8_SB(0, 0), b2, voffB); PG8_STAGE(PG8_SB(0, 1), b2 + hstepB, voffB); PG8_STAGE_A(PG8_SA(0, 0), a2, voffA);
            PG8_WAIT_V(8); PG8_WAIT_L(0); PG8_BAR; PG8_MMA(1, 0, At, B0); PG8_MMA(1, 1, At, B1); PG8_BAR; PG8_SCHED;
            if constexpr (Epi::NDEFER > 0) { if (pend) { int fr_ = fr, fq_ = fq; asm volatile("" : "+v"(fr_), "+v"(fq_)); E.flush(carry, 1, prev, wr, wc, fr_, fq_); } }
            PG8_LDB(B0, 1, 0); PG8_LDB(B1, 1, 1); PG8_SCHED; PG8_LDA(At, 1, 0); PG8_STAGE_A(PG8_SA(0, 1), a2 + hstepA, voffA);
            PG8_WAIT_V(8); PG8_WAIT_L(0); PG8_BAR; PG8_MMA(0, 0, At, B0); PG8_MMA(0, 1, At, B1); PG8_BAR; PG8_SCHED;
            if constexpr (Epi::NDEFER > 0) { if (pend && Epi::NDEFER > 2) E.flush(carry, 2, prev, wr, wc, fr, fq); }
            PG8_LDA(At, 1, 1); PG8_STAGE(PG8_SB(1, 0), b3, voffB); PG8_STAGE(PG8_SB(1, 1), b3 + hstepB, voffB); PG8_STAGE_A(PG8_SA(1, 0), a3, voffA);
            PG8_WAIT_V(8); PG8_WAIT_L(0); PG8_BAR; PG8_MMA(1, 0, At, B0); PG8_MMA(1, 1, At, B1); PG8_BAR; PG8_SCHED;
            if constexpr (Epi::NDEFER > 0) { if (pend && Epi::NDEFER > 3) E.flush(carry, 3, prev, wr, wc, fr, fq); }
        }
        if constexpr (ALIGN_EPI) { if (wr == 0) PG8_BAR; }
        { int fr_ = fr, fq_ = fq; asm volatile("" : "+v"(fr_), "+v"(fq_));
          if constexpr (Epi::NDEFER > 0) E.run(acc, cur, wr, wc, fr_, fq_, carry, has_next); else E(acc, cur, wr, wc, fr_, fq_); }
        S.done(cur); prev = cur;
        if (!has_next) break;
#pragma unroll
        for (int a = 0; a < 2; ++a)
#pragma unroll
            for (int b = 0; b < 2; ++b)
#pragma unroll
                for (int m = 0; m < 4; ++m)
#pragma unroll
                    for (int n = 0; n < 2; ++n) acc[a][b][m][n] = (f32x4){0.f, 0.f, 0.f, 0.f};
        cur = nxt; cA = nA; cB = nB; ++ui;
        if constexpr (ALIGN_EPI) { if (wr == 1) PG8_BAR; }
    }
    PG8_WAIT_V(0);
    if constexpr (!ALIGN_EPI) { if (wr == 0) PG8_BAR; }
    PG8_BAR;
#undef PG8_SA
#undef PG8_SB
#undef PG8_STAGE
#undef PG8_STAGE_A
#undef PG8_LDA
#undef PG8_LDB
#undef PG8_MMA
#undef PG8_WAIT_V
#undef PG8_WAIT_L
#undef PG8_BAR
#undef PG8_SCHED
}
}

constexpr int NWAVES = 8, NTHREADS = NWAVES * 64;
constexpr int N_LAUNCHES = MK_N_LAUNCHES;
constexpr int N_PHASES = 10;
constexpr int DM = 1024, SEQ = 2048, NSEQ_P = 8, NSEQ = 24, T_P = NSEQ_P * SEQ, TT = NSEQ * SEQ;
constexpr int RW = 512, NHEAD = 4, DH = 128, INW = 2560, DFF = 2816, NUP = 2 * DFF;
constexpr int SG = 32, SCH = 16, SNS = 64;
constexpr float EPS = 1e-6f;

typedef unsigned short bf16;
typedef float f32x4 __attribute__((ext_vector_type(4)));
typedef unsigned v4u __attribute__((ext_vector_type(4)));
typedef unsigned v2u __attribute__((ext_vector_type(2)));
#define GAS __attribute__((address_space(1)))
#define LAS __attribute__((address_space(3)))
typedef GAS unsigned gu32;
#define RLX_AGENT __ATOMIC_RELAXED, __HIP_MEMORY_SCOPE_AGENT
#define LDS_WAIT() asm volatile("s_waitcnt lgkmcnt(0)" ::: "memory")

constexpr size_t MiB = 1u << 20;
constexpr size_t WS_CTL = 0, CTL_ZERO_BYTES = 1 * MiB;
constexpr size_t WS_ROT = 1 * MiB;
constexpr size_t WS_SS1 = 256 * 1024, WS_SS2 = 512 * 1024;
constexpr int CW_UXRDY = 6144;
constexpr int CW_PANEL = 8192;
constexpr size_t WS_WIN = 4 * MiB, WS_WGLU = 9 * MiB, WS_WOUT = 10 * MiB, WS_WUP = 12 * MiB, WS_WDN = 23 * MiB;
constexpr size_t WS_BTY = 29 * MiB, WS_BTE = 37 * MiB, WS_A16 = 41 * MiB;
constexpr size_t WS_H1 = 48 * MiB;
constexpr size_t WS_RMS1 = 2 * MiB;
constexpr size_t WS_Q = 144 * MiB, WS_K = 192 * MiB, WS_V = 240 * MiB, WS_G = 288 * MiB;
constexpr size_t WS_UX = 336 * MiB;
constexpr size_t WS_YB = 432 * MiB;
constexpr size_t WS_ACT = 48 * MiB;
constexpr size_t WS_X2B = 312 * MiB;
constexpr size_t WS_ZB = 408 * MiB;
constexpr size_t WS_END = 480 * MiB;
static_assert(WS_ACT + (size_t)TT * DFF * 2 <= WS_X2B && WS_X2B + (size_t)TT * DM * 2 <= WS_ZB && WS_ZB + (size_t)768 * 4 * NUP * 2 <= WS_END, "ws map");
constexpr int CW_BAR = 1024;

constexpr int RING_BYTES = 131072;
constexpr int LDSCTL_OFF = RING_BYTES, MISC_OFF = LDSCTL_OFF + 320;
constexpr int LDS_BYTES = 147456;

__device__ __forceinline__ unsigned f2bf(float f) { unsigned u = __builtin_bit_cast(unsigned, f); return (u + 0x7fffu + ((u >> 16) & 1u)) >> 16; }
__device__ __forceinline__ unsigned pk2(float lo, float hi) { return f2bf(lo) | (f2bf(hi) << 16); }
__device__ __forceinline__ float bf_lo(unsigned w) { return __builtin_bit_cast(float, w << 16); }
__device__ __forceinline__ float bf_hi(unsigned w) { return __builtin_bit_cast(float, w & 0xffff0000u); }
__device__ __forceinline__ float gelu_tanh(float x) {
    const float t = x * (1.0f + 0.044715f * x * x) * (-2.0f * 0.7978845608028654f * 1.4426950408889634f);
    return x * __builtin_amdgcn_rcpf(1.0f + __builtin_amdgcn_exp2f(t));
}
__device__ __forceinline__ float sigmoidf_(float x) { return __builtin_amdgcn_rcpf(1.0f + __builtin_amdgcn_exp2f(-1.4426950408889634f * x)); }
__device__ __forceinline__ f32x4 gelu_mul4(f32x4 g, f32x4 v) {
    const float c1 = -2.0f * 0.7978845608028654f * 1.4426950408889634f, c2 = c1 * 0.044715f;
    const f32x4 u = g * g, p = u * c2 + c1, t = g * p;
    f32x4 d; d[0] = __builtin_amdgcn_exp2f(t[0]); d[1] = __builtin_amdgcn_exp2f(t[1]); d[2] = __builtin_amdgcn_exp2f(t[2]); d[3] = __builtin_amdgcn_exp2f(t[3]);
    d = d + 1.0f;
    f32x4 r; r[0] = __builtin_amdgcn_rcpf(d[0]); r[1] = __builtin_amdgcn_rcpf(d[1]); r[2] = __builtin_amdgcn_rcpf(d[2]); r[3] = __builtin_amdgcn_rcpf(d[3]);
    return (g * v) * r;
}
__device__ __forceinline__ f32x4 gelu4(f32x4 g) {
    const float c1 = -2.0f * 0.7978845608028654f * 1.4426950408889634f, c2 = c1 * 0.044715f;
    const f32x4 u = g * g, p = u * c2 + c1, t = g * p;
    f32x4 d; d[0] = __builtin_amdgcn_exp2f(t[0]); d[1] = __builtin_amdgcn_exp2f(t[1]); d[2] = __builtin_amdgcn_exp2f(t[2]); d[3] = __builtin_amdgcn_exp2f(t[3]);
    d = d + 1.0f;
    f32x4 r; r[0] = __builtin_amdgcn_rcpf(d[0]); r[1] = __builtin_amdgcn_rcpf(d[1]); r[2] = __builtin_amdgcn_rcpf(d[2]); r[3] = __builtin_amdgcn_rcpf(d[3]);
    return g * r;
}
__device__ __forceinline__ f32x4 sigmoid4(f32x4 x) {
    const f32x4 t = x * (-1.4426950408889634f);
    f32x4 d; d[0] = __builtin_amdgcn_exp2f(t[0]); d[1] = __builtin_amdgcn_exp2f(t[1]); d[2] = __builtin_amdgcn_exp2f(t[2]); d[3] = __builtin_amdgcn_exp2f(t[3]);
    d = d + 1.0f;
    return (f32x4){__builtin_amdgcn_rcpf(d[0]), __builtin_amdgcn_rcpf(d[1]), __builtin_amdgcn_rcpf(d[2]), __builtin_amdgcn_rcpf(d[3])};
}
__device__ __forceinline__ float wave_sum(float v) {
#pragma unroll
    for (int o = 1; o < 64; o <<= 1) v += __shfl_xor(v, o);
    return v;
}

#define XB_TMO      128
#define XB_XCNT(j)  (256  + 64 * (j))
#define XB_XSUB(j)  (1280 + 64 * (j))
#define XB_XGEN(j)  (2304 + 64 * (j))
#define XB_TOP      3328
#define XB_TOPGEN   3392
#define XCD_BAR_WORDS 3456
#define XB_SPIN_CAP (1u << 24)
__device__ __forceinline__ unsigned xb_ld(unsigned* p)              { return __hip_atomic_load(p, __ATOMIC_RELAXED, __HIP_MEMORY_SCOPE_AGENT); }
__device__ __forceinline__ unsigned xb_add(unsigned* p, unsigned v) { return __hip_atomic_fetch_add(p, v, __ATOMIC_RELAXED, __HIP_MEMORY_SCOPE_AGENT); }
__device__ __forceinline__ unsigned xb_xcc_id() { return (unsigned)__builtin_amdgcn_s_getreg((3 << 11) | 20) & 0xFu; }
#define XB_SPIN(cond, bar) do { unsigned _sp = 0; while (cond) { __builtin_amdgcn_s_sleep(1); \
    if ((++_sp & 255u) == 0u) { if (xb_ld(&(bar)[XB_TMO])) break; if (_sp > XB_SPIN_CAP) { atomicAdd(&(bar)[XB_TMO], 1u); break; } } } } while (0)
struct XcdBarrier { unsigned* bar; unsigned x; volatile LAS unsigned* st; };
__device__ __forceinline__ XcdBarrier xcd_barrier_post(unsigned* bar, volatile LAS unsigned* st) {
    XcdBarrier b; b.bar = bar; b.x = xb_xcc_id(); b.st = st;
    if (threadIdx.x == 0) (void)xb_add(&bar[XB_XCNT(b.x)], 1u);
    return b;
}
__device__ __forceinline__ void xcd_barrier_complete(unsigned* bar, unsigned x, unsigned& nloc, unsigned& nx) {
    const unsigned G = gridDim.x * gridDim.y * gridDim.z;
    unsigned sum, cnt, mine, sp = 0u;
    for (;;) {
        sum = 0u; cnt = 0u; mine = 0u;
#pragma unroll
        for (unsigned j = 0; j < 16; ++j) { const unsigned c = xb_ld(&bar[XB_XCNT(j)]); sum += c; cnt += (c > 0u) ? 1u : 0u; mine = (j == x) ? c : mine; }
        if (sum == G) break;
        __builtin_amdgcn_s_sleep(1);
        if ((++sp & 255u) == 0u) { if (xb_ld(&bar[XB_TMO])) break; if (sp > XB_SPIN_CAP) { atomicAdd(&bar[XB_TMO], 1u); break; } }
    }
    nloc = mine > 0u ? mine : 1u; nx = cnt > 0u ? cnt : 1u;
}
__device__ __forceinline__ void xcd_barrier(const XcdBarrier& b) {
    asm volatile("s_waitcnt vmcnt(0)" ::: "memory");
    __syncthreads();
    if (threadIdx.x == 0) {
        unsigned* bar = b.bar;
        __builtin_amdgcn_s_waitcnt(0);
        unsigned nloc = b.st[0], nx = b.st[1];
        if (nloc == 0u) { xcd_barrier_complete(bar, b.x, nloc, nx); b.st[0] = nloc; b.st[1] = nx; }
        const unsigned old = xb_add(&bar[XB_XSUB(b.x)], 1u);
        const unsigned gen = old / nloc;
        if (old + 1u == (gen + 1u) * nloc) {
            __builtin_amdgcn_fence(__ATOMIC_RELEASE, "agent");
            asm volatile("s_waitcnt vmcnt(0)" ::: "memory");
            const unsigned og = xb_add(&bar[XB_TOP], 1u);
            const unsigned tg = og / nx;
            if (og + 1u == (tg + 1u) * nx) xb_add(&bar[XB_TOPGEN], 1u);
            else XB_SPIN(xb_ld(&bar[XB_TOPGEN]) == tg, bar);
            __builtin_amdgcn_fence(__ATOMIC_ACQUIRE, "agent");
            asm volatile("s_waitcnt vmcnt(0)" ::: "memory");
        } else {
            XB_SPIN(xb_ld(&bar[XB_TOPGEN]) == gen, bar);
            __builtin_amdgcn_fence(__ATOMIC_ACQUIRE, "agent");
            asm volatile("s_waitcnt vmcnt(0)" ::: "memory");
        }
    }
    __syncthreads();
}

struct Args { const float* in[22]; float* out; unsigned char* ws; int ph_lo, ph_hi; };
enum { I_XP = 0, I_XS, I_NMIX, I_WIN, I_GN, I_LRE, I_LIM, I_LDT, I_BRE, I_BIM, I_CRE, I_CIM, I_SD, I_GLUW, I_GLUB, I_WOUT, I_NFFN, I_WUP, I_CONVW, I_CONVB, I_WDN, I_NFIN };

template <int MODE>
__device__ __forceinline__ int w_dst_row(int n) {
    if (MODE == 1) {
        if (n >= 2 * RW) return n;
        const int sec = n >> 9, hh = (n >> 7) & 3, d = n & 127, nb = d >> 6, j = d & 63;
        const int p = 32 * (j >> 4) + 8 * ((j >> 2) & 3) + 4 * nb + (j & 3);
        return sec * RW + hh * DH + p;
    } else if (MODE == 2) {
        const int gate = n >= DFF ? 1 : 0, c = n - gate * DFF;
        return (c >> 7) * 256 + gate * 128 + (c & 127);
    }
    return n;
}
template <int MODE>
__device__ __forceinline__ void p0_transpose_item(const float* W, int K, int N, bf16* WT, const float* kgain, LAS float* scr, int item, int lane) {
    const int nblk = N / 32, kb = item / nblk, nb = item % nblk, k0 = 64 * kb, n0 = 32 * nb;
#pragma unroll 8
    for (int i = 0; i < 32; ++i) { const int kk = 2 * i + (lane >> 5); float w = W[(size_t)(k0 + kk) * N + n0 + (lane & 31)]; if (MODE == 2) w *= kgain[k0 + kk]; scr[kk * 33 + (lane & 31)] = w; }
    LDS_WAIT(); asm volatile("" ::: "memory");
    const int c = lane & 7;
#pragma unroll
    for (int j = 0; j < 4; ++j) { const int n = (lane >> 3) + 8 * j; const LAS float* s = scr + (8 * c) * 33 + n;
        const int ng = n0 + n; float sc = 1.0f; if (MODE == 1) { if (ng >= RW && ng < 2 * RW) sc = 0.08838834764831845f; }
        v4u o; o.x = pk2(s[0 * 33] * sc, s[1 * 33] * sc); o.y = pk2(s[2 * 33] * sc, s[3 * 33] * sc); o.z = pk2(s[4 * 33] * sc, s[5 * 33] * sc); o.w = pk2(s[6 * 33] * sc, s[7 * 33] * sc);
        const int nd = w_dst_row<MODE>(ng), nl = nd & 127, x = nl & 31, slot = (nl & ~31) + 16 * ((x >> 2) & 1) + 4 * (x >> 3) + (x & 3);
        const int kk8 = k0 + 8 * c;
        *(GAS v4u*)(WT + ((size_t)(nd >> 7) * (K / 64) + (kk8 >> 6)) * 8192 + pg8::lds_byte(slot, kk8 & 63) / 2) = o; }
    LDS_WAIT(); asm volatile("" ::: "memory");
}
__device__ __forceinline__ const float* x_row(const Args& a, int m) { return m < T_P ? a.in[I_XP] + (size_t)m * DM : a.in[I_XS] + (size_t)(m - T_P) * DM; }

__device__ __forceinline__ void s5_build(const Args& a, LAS unsigned char* lds, int unit, int nparts);
__device__ __forceinline__ void late_weights(const Args& a, LAS unsigned char* lds, int which, int wg, int nwg, int wave, int lane) {
    LAS float* scr = (LAS float*)(lds + wave * 16384);
    constexpr int I_UP = (DM / 64) * (NUP / 32), I_DN = (DFF / 64) * (DM / 32);
    const int gw = wg * NWAVES + wave, NGW = nwg * NWAVES;
    if (which == 0) { for (int it = gw; it < I_UP; it += NGW) p0_transpose_item<2>(a.in[I_WUP], DM, NUP, (bf16*)(a.ws + WS_WUP), a.in[I_NFFN], scr, it, lane); }
    else { for (int it = gw; it < I_DN; it += NGW) p0_transpose_item<0>(a.in[I_WDN], DFF, DM, (bf16*)(a.ws + WS_WDN), nullptr, scr, it, lane); }
}
__device__ __forceinline__ void p0_prologue(const Args& a, LAS unsigned char* lds, int wave, int lane, int vcu, int G) {
    unsigned char* ws = a.ws;
    LAS float* scr = (LAS float*)(lds + wave * 16384);
    const bool split = (G & 1) == 0;
    const bool do_w = !split || (vcu & 1) == 1, do_h = !split || (vcu & 1) == 0;
    const int gw = (split ? (vcu >> 1) : vcu) * NWAVES + wave, NGW = (split ? G / 2 : G) * NWAVES;
    if (do_w) { if (split) { for (int un = 2 * (vcu >> 1); un < SG * 8; un += G) s5_build(a, lds, un, 2); }
                else for (int un = vcu; un < SG * 8; un += G) s5_build(a, lds, un, 1); }
    constexpr int I_IN = (DM / 64) * (INW / 32), I_GLU = (RW / 64) * (RW / 32), I_OUT = (DM / 64) * (DM / 32), I_UP = (DM / 64) * (NUP / 32), I_DN = (DFF / 64) * (DM / 32);
    const int NITEMS = (G == 256) ? I_IN + I_GLU + I_OUT : I_IN + I_GLU + I_OUT + I_UP + I_DN;
    if (do_w) for (int it = gw; it < NITEMS; it += NGW) {
        int r = it;
        if (r < I_IN) { p0_transpose_item<1>(a.in[I_WIN], DM, INW, (bf16*)(ws + WS_WIN), nullptr, scr, r, lane); continue; } r -= I_IN;
        if (r < I_GLU) { p0_transpose_item<0>(a.in[I_GLUW], RW, RW, (bf16*)(ws + WS_WGLU), nullptr, scr, r, lane); continue; } r -= I_GLU;
        if (r < I_OUT) { p0_transpose_item<0>(a.in[I_WOUT], DM, DM, (bf16*)(ws + WS_WOUT), nullptr, scr, r, lane); continue; } r -= I_OUT;
        if (r < I_UP) { p0_transpose_item<2>(a.in[I_WUP], DM, NUP, (bf16*)(ws + WS_WUP), a.in[I_NFFN], scr, r, lane); continue; } r -= I_UP;
        p0_transpose_item<0>(a.in[I_WDN], DFF, DM, (bf16*)(ws + WS_WDN), nullptr, scr, r, lane);
    }
    constexpr int H1_TAIL = 5 * 2048;
    const int TH = split ? TT - H1_TAIL : TT;
    auto h1_rows = [&](int m_begin, int m_end) {
        const GAS f32x4* gn = (const GAS f32x4*)a.in[I_NMIX] + lane;
        f32x4 gv[4];
#pragma unroll
        for (int j = 0; j < 4; ++j) gv[j] = gn[64 * j];
        for (int m = m_begin + gw; m < m_end; m += 2 * NGW) {
            const int m2 = m + NGW; const bool has2 = m2 < m_end;
            const GAS f32x4* xr = (const GAS f32x4*)x_row(a, m) + lane; const GAS f32x4* xr2 = (const GAS f32x4*)x_row(a, has2 ? m2 : m) + lane;
            f32x4 v[4], v2[4]; float s = 0.f, s2 = 0.f;
#pragma unroll
            for (int j = 0; j < 4; ++j) { v[j] = __builtin_nontemporal_load(xr + 64 * j); v2[j] = __builtin_nontemporal_load(xr2 + 64 * j); }
#pragma unroll
            for (int j = 0; j < 4; ++j) { s += (v[j].x * v[j].x + v[j].y * v[j].y) + (v[j].z * v[j].z + v[j].w * v[j].w); s2 += (v2[j].x * v2[j].x + v2[j].y * v2[j].y) + (v2[j].z * v2[j].z + v2[j].w * v2[j].w); }
            const float rms = sqrtf(wave_sum(s) * (1.0f / DM) + EPS), rms2 = sqrtf(wave_sum(s2) * (1.0f / DM) + EPS); const float rinv = 1.0f / rms, rinv2 = 1.0f / rms2;
            if (lane == 0) { ((float*)(ws + WS_RMS1))[m] = rms; if (has2) ((float*)(ws + WS_RMS1))[m2] = rms2; }
            GAS unsigned long long* o8 = (GAS unsigned long long*)((bf16*)(ws + WS_H1) + (size_t)m * DM) + lane;
#pragma unroll
            for (int j = 0; j < 4; ++j) o8[64 * j] = (unsigned long long)pk2(v[j].x * rinv * gv[j].x, v[j].y * rinv * gv[j].y) | ((unsigned long long)pk2(v[j].z * rinv * gv[j].z, v[j].w * rinv * gv[j].w) << 32);
            if (has2) { GAS unsigned long long* o82 = (GAS unsigned long long*)((bf16*)(ws + WS_H1) + (size_t)m2 * DM) + lane;
#pragma unroll
                for (int j = 0; j < 4; ++j) o82[64 * j] = (unsigned long long)pk2(v2[j].x * rinv2 * gv[j].x, v2[j].y * rinv2 * gv[j].y) | ((unsigned long long)pk2(v2[j].z * rinv2 * gv[j].z, v2[j].w * rinv2 * gv[j].w) << 32); }
        }
    };
    if (do_h) h1_rows(0, TH);
    if (do_w) {
        const int gt = gw * 64 + lane, NGT = NGW * 64;
        float* rc = (float*)(ws + WS_ROT); float* rs = rc + SEQ * 64;
        for (int i = gt; i < SEQ * 64; i += NGT) {
            const int pos = i >> 6, f = i & 63;
            const float inv = exp2f(-(float)f * (13.287712379549449f / 64.0f));
            const float ang = (float)pos * inv; float sn, cs; sincosf(ang, &sn, &cs);
            rc[i] = cs; rs[i] = sn;
        }
    }
    if (split && do_w) h1_rows(TH, TT);
}

__device__ __forceinline__ void st16_wt(void* p, v4u w) { asm volatile("global_store_dwordx4 %0, %1, off sc1\n\ts_nop 1" :: "v"(p), "v"(w) : "memory"); }
struct P1Order {
    pg8::StaticOrder su, sr; int G, c; unsigned* cnt;
    __device__ __forceinline__ void init(int G_, int c_, unsigned* cnt_) { su.init(TT, 512, G_, c_, 4); sr.init(TT, 2048, G_, c_, 4); G = G_; c = c_; cnt = cnt_; }
    __device__ __forceinline__ bool next(int i, pg8::Unit& u) const {
        const int L = i * G + c; if (L >= 1920) return false;
        if (L < 384) { su.map(L, u); u.pn += 8; } else sr.map(L - 384, u);
        return true;
    }
    __device__ __forceinline__ void a_ready(const pg8::Unit&) const {}
    __device__ __forceinline__ void done(const pg8::Unit& u) const {
        if (u.pn >= 8) { asm volatile("s_waitcnt vmcnt(0)" ::: "memory");
            if ((threadIdx.x & 63) == 0) __hip_atomic_fetch_add(cnt + 64 * (u.pm >> 4), 1u, __ATOMIC_RELAXED, __HIP_MEMORY_SCOPE_AGENT); }
    }
};
struct S5ESubOrder {
    int G, c; const unsigned* cnt; mutable int seen = 0;
    __device__ __forceinline__ bool next(int i, pg8::Unit& u) const { const int L = i * G + c; if (L >= SG * 12) return false; u.pm = L; u.pn = L / 12; return true; }
    __device__ __forceinline__ void a_ready(const pg8::Unit&) const {
        if (seen) return;
        seen = 1;
        if (threadIdx.x < 64) {
            const int l = threadIdx.x; unsigned sp = 0;
            for (;;) {
                const bool ok = l >= 12 || __hip_atomic_load(cnt + 64 * (l < 12 ? l : 0), __ATOMIC_RELAXED, __HIP_MEMORY_SCOPE_AGENT) >= 256u;
                if (__builtin_amdgcn_ballot_w64(!ok) == 0ull) break;
                if (++sp > (1u << 22)) break;
                __builtin_amdgcn_s_sleep(2);
            }
            __builtin_amdgcn_fence(__ATOMIC_ACQUIRE, "agent");
            asm volatile("s_waitcnt vmcnt(0)" ::: "memory");
        }
        asm volatile("" ::: "memory"); __builtin_amdgcn_s_barrier(); asm volatile("" ::: "memory");
    }
    __device__ __forceinline__ void done(const pg8::Unit&) const {}
};
using pg8::Unit; using pg8::cvt_pk_bf16;
struct EpiIn {
    static constexpr int NDEFER = 0; struct Carry {};
    bf16 *Q, *Kk, *V, *Gt, *UX; const float* rotc; const float* rots;
    __device__ __forceinline__ void operator()(const f32x4 (&acc)[2][2][4][2], const Unit& u, int wr, int wc, int fr, int fq) const {
        const int sec = u.pn >> 1, half = u.pn & 1;
        const int row0 = u.pm * 256 + wr * 64 + fr;
        if (sec < 2) {
            bf16* dst = sec == 0 ? Q : Kk;
            const int f0 = 16 * wc + 4 * fq;
#pragma unroll
            for (int ai = 0; ai < 2; ++ai)
#pragma unroll
                for (int m = 0; m < 4; ++m) {
                    const int row = row0 + ai * 128 + m * 16, pos = row & (SEQ - 1);
                    const f32x4 c = *(const f32x4*)(rotc + pos * 64 + f0), s = *(const f32x4*)(rots + pos * 64 + f0);
#pragma unroll
                    for (int bj = 0; bj < 2; ++bj) {
                        const f32x4 x1 = acc[ai][bj][m][0], x2 = acc[ai][bj][m][1];
                        const f32x4 o1 = x1 * c - x2 * s, o2 = x1 * s + x2 * c;
                        v4u w; w.x = cvt_pk_bf16(o1[0], o1[1]); w.y = cvt_pk_bf16(o1[2], o1[3]); w.z = cvt_pk_bf16(o2[0], o2[1]); w.w = cvt_pk_bf16(o2[2], o2[3]);
                        __builtin_nontemporal_store(w, (v4u*)(dst + (size_t)row * RW + (half * 2 + bj) * DH + 32 * wc + 8 * fq));
                    }
                }
        } else if (sec < 4) {
            bf16* dst = sec == 2 ? V : Gt;
#pragma unroll
            for (int ai = 0; ai < 2; ++ai)
#pragma unroll
                for (int m = 0; m < 4; ++m) {
                    const int row = row0 + ai * 128 + m * 16;
#pragma unroll
                    for (int bj = 0; bj < 2; ++bj) {
                        const f32x4 v0 = acc[ai][bj][m][0], v1 = acc[ai][bj][m][1];
                        v4u w; w.x = cvt_pk_bf16(v0[0], v0[1]); w.y = cvt_pk_bf16(v0[2], v0[3]); w.z = cvt_pk_bf16(v1[0], v1[1]); w.w = cvt_pk_bf16(v1[2], v1[3]);
                        __builtin_nontemporal_store(w, (v4u*)(dst + (size_t)row * RW + half * 256 + bj * 128 + 32 * wc + 8 * fq));
                    }
                }
        } else {
#pragma unroll
            for (int ai = 0; ai < 2; ++ai)
#pragma unroll
                for (int m = 0; m < 4; ++m) {
                    const int row = row0 + ai * 128 + m * 16;
#pragma unroll
                    for (int bj = 0; bj < 2; ++bj) {
                        const int cu = half * 256 + bj * 128 + 32 * wc + 8 * fq, g = cu >> 4, ci0 = cu & 15;
                        const f32x4 v0 = acc[ai][bj][m][0], v1 = acc[ai][bj][m][1];
                        v4u w; w.x = cvt_pk_bf16(v0[0], v0[1]); w.y = cvt_pk_bf16(v0[2], v0[3]); w.z = cvt_pk_bf16(v1[0], v1[1]); w.w = cvt_pk_bf16(v1[2], v1[3]);
                        st16_wt(UX + ((size_t)g * (TT / 16) + (row >> 4)) * 512 + (row & 15) * 16 + ci0, w);
                    }
                }
        }
    }
};
struct EpiGlu {
    static constexpr int NDEFER = 0; struct Carry {};
    const bf16* YB; const float* bias; bf16* MIX;
    __device__ __forceinline__ void operator()(const f32x4 (&acc)[2][2][4][2], const Unit& u, int wr, int wc, int fr, int fq) const {
        const int row0 = u.pm * 256 + wr * 64 + fr, col0 = u.pn * 256 + wc * 32 + 8 * fq;
#pragma unroll
        for (int bj = 0; bj < 2; ++bj) {
            const int c = col0 + bj * 128;
            const f32x4 b0 = *(const f32x4*)(bias + c), b1 = *(const f32x4*)(bias + c + 4);
#pragma unroll
            for (int ai = 0; ai < 2; ++ai)
#pragma unroll
                for (int m = 0; m < 4; ++m) {
                    const int row = row0 + ai * 128 + m * 16;
                    const v4u yw = *(const v4u*)(YB + ((size_t)(c >> 4) * TT + row) * 16 + (c & 15));
                    const f32x4 g0 = acc[ai][bj][m][0] + b0, g1 = acc[ai][bj][m][1] + b1;
                    const f32x4 y0 = (f32x4){bf_lo(yw.x), bf_hi(yw.x), bf_lo(yw.y), bf_hi(yw.y)} * sigmoid4(g0), y1 = (f32x4){bf_lo(yw.z), bf_hi(yw.z), bf_lo(yw.w), bf_hi(yw.w)} * sigmoid4(g1);
                    v4u w; w.x = cvt_pk_bf16(y0[0], y0[1]); w.y = cvt_pk_bf16(y0[2], y0[3]); w.z = cvt_pk_bf16(y1[0], y1[1]); w.w = cvt_pk_bf16(y1[2], y1[3]);
                    *(v4u*)(MIX + (size_t)row * DM + RW + c) = w;
                }
        }
    }
};
template <bool DRY> struct EpiOutT {
    static constexpr int NDEFER = 0; struct Carry {};
    const bf16* H1; const float* rms1; const float* gmix; bf16* X2B; float* ss1;
    __device__ __forceinline__ void operator()(const f32x4 (&acc)[2][2][4][2], const Unit& u, int wr, int wc, int fr, int fq) const {
        const int row0 = u.pm * 256 + wr * 64 + fr, col0 = u.pn * 256 + wc * 32 + 8 * fq;
        f32x4 gi[2][2];
#pragma unroll
        for (int bj = 0; bj < 2; ++bj)
#pragma unroll
            for (int h = 0; h < 2; ++h) { const f32x4 gq = *(const f32x4*)(gmix + col0 + bj * 128 + 4 * h);
                gi[bj][h] = (f32x4){__builtin_amdgcn_rcpf(gq[0]), __builtin_amdgcn_rcpf(gq[1]), __builtin_amdgcn_rcpf(gq[2]), __builtin_amdgcn_rcpf(gq[3])}; }
#pragma unroll
        for (int ai = 0; ai < 2; ++ai) {
            float sm[4];
#pragma unroll
            for (int m = 0; m < 4; ++m) {
                const int row = row0 + ai * 128 + m * 16; float s = 0.f;
                const float rm = rms1[row];
#pragma unroll
                for (int bj = 0; bj < 2; ++bj) {
                    const size_t off = (size_t)row * DM + col0 + bj * 128;
                    const v4u hw = *(const v4u*)(H1 + off);
                    const f32x4 r0 = (f32x4){bf_lo(hw.x), bf_hi(hw.x), bf_lo(hw.y), bf_hi(hw.y)} * gi[bj][0] * rm, r1 = (f32x4){bf_lo(hw.z), bf_hi(hw.z), bf_lo(hw.w), bf_hi(hw.w)} * gi[bj][1] * rm;
                    const f32x4 v0 = acc[ai][bj][m][0] + r0, v1 = acc[ai][bj][m][1] + r1;
                    v4u w; w.x = cvt_pk_bf16(v0[0], v0[1]); w.y = cvt_pk_bf16(v0[2], v0[3]); w.z = cvt_pk_bf16(v1[0], v1[1]); w.w = cvt_pk_bf16(v1[2], v1[3]);
                    if (!DRY) *(v4u*)(X2B + off) = w; else asm volatile("" :: "v"(w));
                    s += (v0[0] * v0[0] + v0[1] * v0[1]) + (v0[2] * v0[2] + v0[3] * v0[3]) + (v1[0] * v1[0] + v1[1] * v1[1]) + (v1[2] * v1[2] + v1[3] * v1[3]);
                }
                s += __shfl_xor(s, 16); s += __shfl_xor(s, 32);
                sm[m] = s;
            }
            const float sv = fq == 0 ? sm[0] : fq == 1 ? sm[1] : fq == 2 ? sm[2] : sm[3];
            if (!DRY) atomicAdd(ss1 + row0 + ai * 128 + fq * 16, sv); else asm volatile("" :: "v"(sv));
        }
    }
};
__device__ __forceinline__ float dpp_prev(float v) { return __builtin_bit_cast(float, __builtin_amdgcn_mov_dpp(__builtin_bit_cast(int, v), 0x121, 0xf, 0xf, false)); }
__device__ __forceinline__ float dpp_next(float v) { return __builtin_bit_cast(float, __builtin_amdgcn_mov_dpp(__builtin_bit_cast(int, v), 0x12F, 0xf, 0xf, false)); }
__device__ __forceinline__ f32x4 dpp_prev4(f32x4 v) { return (f32x4){dpp_prev(v[0]), dpp_prev(v[1]), dpp_prev(v[2]), dpp_prev(v[3])}; }
__device__ __forceinline__ f32x4 dpp_next4(f32x4 v) { return (f32x4){dpp_next(v[0]), dpp_next(v[1]), dpp_next(v[2]), dpp_next(v[3])}; }
struct EpiUp {
    static constexpr int NDEFER = 0; struct Carry { v4u w[2]; };
    bf16* ACT; bf16* ZB; const float* ss1; const float* cw; const float* cb;
    __device__ __forceinline__ void flush(const Carry& c, int j, const Unit& u, int wr, int wc, int fr, int fq) const {
        bf16* p = ACT + (size_t)(u.pm * 256 + wr * 128 + 4 * fr + 64 + 2 + j) * DFF + u.pn * 128 + wc * 32 + fq * 8;
        __builtin_nontemporal_store(c.w[j], (v4u*)p);
    }
    __device__ __forceinline__ void operator()(const f32x4 (&acc)[2][2][4][2], const Unit& u, int wr, int wc, int fr, int fq) const { Carry c; run(acc, u, wr, wc, fr, fq, c, false); }
    __device__ __forceinline__ void run(const f32x4 (&acc)[2][2][4][2], const Unit& u, int wr, int wc, int fr, int fq, Carry& carry, bool defer) const {
        const int rowb = u.pm * 256 + wr * 128 + 4 * fr;
        const int ch0 = u.pn * 128 + wc * 32 + fq * 8;
        f32x4 rinv[2];
#pragma unroll
        for (int ai = 0; ai < 2; ++ai) { const f32x4 q = *(const f32x4*)(ss1 + rowb + ai * 64);
            const f32x4 qq = q * (1.0f / DM) + EPS;
            rinv[ai] = (f32x4){__builtin_amdgcn_rsqf(qq[0]), __builtin_amdgcn_rsqf(qq[1]), __builtin_amdgcn_rsqf(qq[2]), __builtin_amdgcn_rsqf(qq[3])}; }
        unsigned pk[2][4][2];
        v2u zs[2][4];
#pragma unroll
        for (int n = 0; n < 2; ++n) {
            const int cch = ch0 + 4 * n;
            const f32x4 w0v = *(const f32x4*)(cw + cch), w1v = *(const f32x4*)(cw + NUP + cch), w2v = *(const f32x4*)(cw + 2 * NUP + cch), bv = *(const f32x4*)(cb + cch);
            const f32x4 w0g = *(const f32x4*)(cw + DFF + cch), w1g = *(const f32x4*)(cw + NUP + DFF + cch), w2g = *(const f32x4*)(cw + 2 * NUP + DFF + cch), bg = *(const f32x4*)(cb + DFF + cch);
#pragma unroll
            for (int ai = 0; ai < 2; ++ai) {
                f32x4 zv[4], zg[4];
#pragma unroll
                for (int m = 0; m < 4; ++m) { zv[m] = acc[ai][0][m][n] * rinv[ai][m]; zg[m] = acc[ai][1][m][n] * rinv[ai][m]; }
                f32x4 pzv, nzv, pzg, nzg;
                if (ai == 0) { const f32x4 ov = acc[1][0][0][n] * rinv[1][0], og = acc[1][1][0][n] * rinv[1][0];
                    pzv = dpp_prev4(zv[3]); pzg = dpp_prev4(zg[3]); nzv = dpp_next4(fr == 0 ? ov : zv[0]); nzg = dpp_next4(fr == 0 ? og : zg[0]); }
                else { const f32x4 ov = acc[0][0][3][n] * rinv[0][3], og = acc[0][1][3][n] * rinv[0][3];
                    pzv = dpp_prev4(fr == 15 ? ov : zv[3]); pzg = dpp_prev4(fr == 15 ? og : zg[3]); nzv = dpp_next4(zv[0]); nzg = dpp_next4(zg[0]); }
#pragma unroll
                for (int m = 0; m < 4; ++m) {
                    const f32x4 prv = m > 0 ? zv[m > 0 ? m - 1 : 0] : pzv, nxv = m < 3 ? zv[m < 3 ? m + 1 : 3] : nzv;
                    const f32x4 prg = m > 0 ? zg[m > 0 ? m - 1 : 0] : pzg, nxg = m < 3 ? zg[m < 3 ? m + 1 : 3] : nzg;
                    const f32x4 cv = w0v * prv + (w1v * zv[m] + (w2v * nxv + bv));
                    const f32x4 cg = w0g * prg + (w1g * zg[m] + (w2g * nxg + bg));
                    const f32x4 av = gelu_mul4(cg, cv);
                    const unsigned p0 = cvt_pk_bf16(av[0], av[1]), p1 = cvt_pk_bf16(av[2], av[3]);
                    if (n == 0) { pk[ai][m][0] = p0; pk[ai][m][1] = p1; }
                    else { v4u w; w.x = pk[ai][m][0]; w.y = pk[ai][m][1]; w.z = p0; w.w = p1;
                        if (ai == 1 && m >= 2) carry.w[m - 2] = w;
                        if (ai == 0 || m < 2 || !defer) __builtin_nontemporal_store(w, (v4u*)(ACT + (size_t)(rowb + ai * 64 + m) * DFF + ch0)); }
                }
                if (ai == 0 ? fr == 0 : fr == 15) {
                    const int blk = u.pm * 2 + wr;
                    bf16* zrow = ZB + ((size_t)blk * 4 + (ai == 0 ? 0 : 2)) * NUP;
                    const int m0 = ai == 0 ? 0 : 2;
                    v2u a0, a1, g0, g1;
                    if (ai == 0) { a0 = (v2u){cvt_pk_bf16(zv[0][0], zv[0][1]), cvt_pk_bf16(zv[0][2], zv[0][3])}; a1 = (v2u){cvt_pk_bf16(zv[1][0], zv[1][1]), cvt_pk_bf16(zv[1][2], zv[1][3])};
                                   g0 = (v2u){cvt_pk_bf16(zg[0][0], zg[0][1]), cvt_pk_bf16(zg[0][2], zg[0][3])}; g1 = (v2u){cvt_pk_bf16(zg[1][0], zg[1][1]), cvt_pk_bf16(zg[1][2], zg[1][3])}; }
                    else { a0 = (v2u){cvt_pk_bf16(zv[2][0], zv[2][1]), cvt_pk_bf16(zv[2][2], zv[2][3])}; a1 = (v2u){cvt_pk_bf16(zv[3][0], zv[3][1]), cvt_pk_bf16(zv[3][2], zv[3][3])};
                           g0 = (v2u){cvt_pk_bf16(zg[2][0], zg[2][1]), cvt_pk_bf16(zg[2][2], zg[2][3])}; g1 = (v2u){cvt_pk_bf16(zg[3][0], zg[3][1]), cvt_pk_bf16(zg[3][2], zg[3][3])}; }
                    (void)m0;
                    if (n == 0) { zs[ai][0] = a0; zs[ai][1] = g0; zs[ai][2] = a1; zs[ai][3] = g1; }
                    else { *(v4u*)(zrow + ch0) = (v4u){zs[ai][0].x, zs[ai][0].y, a0.x, a0.y}; *(v4u*)(zrow + DFF + ch0) = (v4u){zs[ai][1].x, zs[ai][1].y, g0.x, g0.y};
                           *(v4u*)(zrow + NUP + ch0) = (v4u){zs[ai][2].x, zs[ai][2].y, a1.x, a1.y}; *(v4u*)(zrow + NUP + DFF + ch0) = (v4u){zs[ai][3].x, zs[ai][3].y, g1.x, g1.y}; }
                }
            }
        }
    }
};
struct EpiDownNorm {
    static constexpr int NDEFER = 0; struct Carry {};
    float* X; const bf16* X2B; float* ss2; unsigned* cnt; const float* gain;
    __device__ __forceinline__ void operator()(f32x4 (&acc)[2][2][4][2], const Unit& u, int wr, int wc, int fr, int fq) const {
        const int row0 = u.pm * 256 + wr * 64 + fr, col0 = u.pn * 256 + wc * 32 + 8 * fq;
#pragma unroll
        for (int ai = 0; ai < 2; ++ai) {
            float sm[4];
#pragma unroll
            for (int m = 0; m < 4; ++m) {
                const int row = row0 + ai * 128 + m * 16; float s = 0.f;
#pragma unroll
                for (int bj = 0; bj < 2; ++bj) {
                    const v4u rw = *(const v4u*)(X2B + (size_t)row * DM + col0 + bj * 128);
                    const f32x4 r0 = (f32x4){bf_lo(rw.x), bf_hi(rw.x), bf_lo(rw.y), bf_hi(rw.y)}, r1 = (f32x4){bf_lo(rw.z), bf_hi(rw.z), bf_lo(rw.w), bf_hi(rw.w)};
                    const f32x4 v0 = acc[ai][bj][m][0] + r0, v1 = acc[ai][bj][m][1] + r1;
                    acc[ai][bj][m][0] = v0; acc[ai][bj][m][1] = v1;
                    s += (v0[0] * v0[0] + v0[1] * v0[1]) + (v0[2] * v0[2] + v0[3] * v0[3]) + (v1[0] * v1[0] + v1[1] * v1[1]) + (v1[2] * v1[2] + v1[3] * v1[3]);
                }
                s += __shfl_xor(s, 16); s += __shfl_xor(s, 32);
                sm[m] = s;
            }
            const float sv = fq == 0 ? sm[0] : fq == 1 ? sm[1] : fq == 2 ? sm[2] : sm[3];
            atomicAdd(ss2 + row0 + ai * 128 + fq * 16, sv);
        }
        asm volatile("s_waitcnt vmcnt(0)" ::: "memory");
        unsigned* pc = cnt + 64 * u.pm;
        if ((threadIdx.x & 63) == 0) __hip_atomic_fetch_add(pc, 1u, __ATOMIC_RELAXED, __HIP_MEMORY_SCOPE_AGENT);
        f32x4 gv[2][2];
#pragma unroll
        for (int bj = 0; bj < 2; ++bj) { gv[bj][0] = *(const f32x4*)(gain + col0 + bj * 128); gv[bj][1] = *(const f32x4*)(gain + col0 + bj * 128 + 4); }
        for (unsigned sp = 0; sp < (1u << 22); ++sp) {
            if ((unsigned)__builtin_amdgcn_readfirstlane((int)__hip_atomic_load(pc, __ATOMIC_RELAXED, __HIP_MEMORY_SCOPE_AGENT)) >= 32u) break;
            __builtin_amdgcn_s_sleep(2);
        }
#pragma unroll
        for (int ai = 0; ai < 2; ++ai)
#pragma unroll
            for (int m = 0; m < 4; ++m) {
                const int row = row0 + ai * 128 + m * 16;
                const float ssv = __hip_atomic_load(ss2 + row, __ATOMIC_RELAXED, __HIP_MEMORY_SCOPE_AGENT);
                const float rinv = 1.0f / sqrtf(ssv * (1.0f / DM) + EPS);
#pragma unroll
                for (int bj = 0; bj < 2; ++bj) {
                    float* op = X + (size_t)row * DM + col0 + bj * 128;
                    *(f32x4*)op = acc[ai][bj][m][0] * rinv * gv[bj][0]; *(f32x4*)(op + 4) = acc[ai][bj][m][1] * rinv * gv[bj][1];
                }
            }
    }
};

__device__ __forceinline__ void ret_naive(const Args& a, LAS unsigned char* lds, int G) {
    constexpr int LD = 132;
    LAS float* Qs = (LAS float*)lds; LAS float* Ks = Qs + 64 * LD; LAS float* Vs = Ks + 64 * LD; LAS float* Ss = Vs + 64 * LD;
    const bf16* Q = (const bf16*)(a.ws + WS_Q); const bf16* K = (const bf16*)(a.ws + WS_K); const bf16* V = (const bf16*)(a.ws + WS_V); const bf16* Gt = (const bf16*)(a.ws + WS_G);
    bf16* MIX = (bf16*)a.out;
    const int tid = threadIdx.x, lr = tid >> 3, lc = (tid & 7) * 16;
    for (int unit = blockIdx.x; unit < NSEQ * NHEAD * 32; unit += G) {
        const int b = unit >> 7, h = (unit >> 5) & 3, qt = unit & 31;
        const size_t rowbase = (size_t)b * SEQ;
        const float lg2 = log2f(1.0f - exp2f(-5.0f - (float)h));
        __syncthreads();
        { const v4u* src = (const v4u*)(Q + (rowbase + qt * 64 + lr) * RW + h * DH + lc); const v4u w0 = src[0], w1 = src[1]; LAS float* d = Qs + lr * LD + lc;
          d[0] = bf_lo(w0.x); d[1] = bf_hi(w0.x); d[2] = bf_lo(w0.y); d[3] = bf_hi(w0.y); d[4] = bf_lo(w0.z); d[5] = bf_hi(w0.z); d[6] = bf_lo(w0.w); d[7] = bf_hi(w0.w);
          d[8] = bf_lo(w1.x); d[9] = bf_hi(w1.x); d[10] = bf_lo(w1.y); d[11] = bf_hi(w1.y); d[12] = bf_lo(w1.z); d[13] = bf_hi(w1.z); d[14] = bf_lo(w1.w); d[15] = bf_hi(w1.w); }
        float o[16];
#pragma unroll
        for (int j = 0; j < 16; ++j) o[j] = 0.f;
        for (int kt = 0; kt < 32; ++kt) {
            __syncthreads();
            { const v4u* src = (const v4u*)(K + (rowbase + kt * 64 + lr) * RW + h * DH + lc); const v4u w0 = src[0], w1 = src[1]; LAS float* d = Ks + lr * LD + lc;
              d[0] = bf_lo(w0.x); d[1] = bf_hi(w0.x); d[2] = bf_lo(w0.y); d[3] = bf_hi(w0.y); d[4] = bf_lo(w0.z); d[5] = bf_hi(w0.z); d[6] = bf_lo(w0.w); d[7] = bf_hi(w0.w);
              d[8] = bf_lo(w1.x); d[9] = bf_hi(w1.x); d[10] = bf_lo(w1.y); d[11] = bf_hi(w1.y); d[12] = bf_lo(w1.z); d[13] = bf_hi(w1.z); d[14] = bf_lo(w1.w); d[15] = bf_hi(w1.w); }
            { const v4u* src = (const v4u*)(V + (rowbase + kt * 64 + lr) * RW + h * DH + lc); const v4u w0 = src[0], w1 = src[1]; LAS float* d = Vs + lr * LD + lc;
              d[0] = bf_lo(w0.x); d[1] = bf_hi(w0.x); d[2] = bf_lo(w0.y); d[3] = bf_hi(w0.y); d[4] = bf_lo(w0.z); d[5] = bf_hi(w0.z); d[6] = bf_lo(w0.w); d[7] = bf_hi(w0.w);
              d[8] = bf_lo(w1.x); d[9] = bf_hi(w1.x); d[10] = bf_lo(w1.y); d[11] = bf_hi(w1.y); d[12] = bf_lo(w1.z); d[13] = bf_hi(w1.z); d[14] = bf_lo(w1.w); d[15] = bf_hi(w1.w); }
            __syncthreads();
            {
                float s[8];
#pragma unroll
                for (int jj = 0; jj < 8; ++jj) s[jj] = 0.f;
                for (int d4 = 0; d4 < 32; ++d4) {
                    const f32x4 qv = *(const LAS f32x4*)(Qs + lr * LD + d4 * 4);
#pragma unroll
                    for (int jj = 0; jj < 8; ++jj) { const f32x4 kv = *(const LAS f32x4*)(Ks + ((tid & 7) + 8 * jj) * LD + d4 * 4); s[jj] += (qv[0] * kv[0] + qv[1] * kv[1]) + (qv[2] * kv[2] + qv[3] * kv[3]); }
                }
#pragma unroll
                for (int jj = 0; jj < 8; ++jj) { const int m = (tid & 7) + 8 * jj; const int dist = abs((qt * 64 + lr) - (kt * 64 + m)); Ss[lr * 65 + m] = s[jj] * exp2f(lg2 * (float)dist); }
            }
            __syncthreads();
            for (int m = 0; m < 64; ++m) {
                const float sv = Ss[lr * 65 + m];
#pragma unroll
                for (int j4 = 0; j4 < 4; ++j4) { const f32x4 vv = *(const LAS f32x4*)(Vs + m * LD + lc + j4 * 4); o[j4 * 4 + 0] += sv * vv[0]; o[j4 * 4 + 1] += sv * vv[1]; o[j4 * 4 + 2] += sv * vv[2]; o[j4 * 4 + 3] += sv * vv[3]; }
            }
        }
        float ss = 0.f;
#pragma unroll
        for (int j = 0; j < 16; ++j) ss += o[j] * o[j];
        ss += __shfl_xor(ss, 1); ss += __shfl_xor(ss, 2); ss += __shfl_xor(ss, 4);
        const float rn = 1.0f / sqrtf(ss * (1.0f / DH) + EPS);
        const size_t row = rowbase + qt * 64 + lr;
        const v4u* gsrc = (const v4u*)(Gt + row * RW + h * DH + lc); const v4u g0 = gsrc[0], g1 = gsrc[1];
        const float gg[16] = {bf_lo(g0.x), bf_hi(g0.x), bf_lo(g0.y), bf_hi(g0.y), bf_lo(g0.z), bf_hi(g0.z), bf_lo(g0.w), bf_hi(g0.w), bf_lo(g1.x), bf_hi(g1.x), bf_lo(g1.y), bf_hi(g1.y), bf_lo(g1.z), bf_hi(g1.z), bf_lo(g1.w), bf_hi(g1.w)};
        const float* gain = a.in[I_GN] + h * DH + lc;
        unsigned w[8];
#pragma unroll
        for (int j = 0; j < 8; ++j) { const float r0 = gg[2 * j] * sigmoidf_(gg[2 * j]) * gain[2 * j] * o[2 * j] * rn, r1 = gg[2 * j + 1] * sigmoidf_(gg[2 * j + 1]) * gain[2 * j + 1] * o[2 * j + 1] * rn; w[j] = pk2(r0, r1); }
        v4u* dst = (v4u*)(MIX + row * DM + h * DH + lc);
        dst[0] = (v4u){w[0], w[1], w[2], w[3]}; dst[1] = (v4u){w[4], w[5], w[6], w[7]};
    }
}
__device__ __forceinline__ void s5_naive(const Args& a, int wave, int lane, int G) {
    const bf16* UX = (const bf16*)(a.ws + WS_UX);
    float* YF = a.out;
    for (int task = blockIdx.x * NWAVES + wave; task < NSEQ * SG * 2; task += G * NWAVES) {
        const int dir = task & 1, g = (task >> 1) & 31, b = task >> 6;
        const int pidx = (dir * SG + g) * SNS + lane;
        const float lr = fminf(a.in[I_LRE][pidx], -1e-4f), li = a.in[I_LIM][pidx], dt = expf(a.in[I_LDT][dir * SG + g]);
        const float mag = expf(lr * dt); const float ar = mag * cosf(li * dt), ai = mag * sinf(li * dt);
        const float den = lr * lr + li * li, nr = ar - 1.0f, ni = ai;
        const float cr = (nr * lr + ni * li) / den, ci = (ni * lr - nr * li) / den;
        float bbr[16], bbi[16], cre[16], cim[16];
#pragma unroll
        for (int c = 0; c < 16; ++c) { const float br = a.in[I_BRE][(size_t)pidx * 16 + c], bi = a.in[I_BIM][(size_t)pidx * 16 + c]; bbr[c] = cr * br - ci * bi; bbi[c] = cr * bi + ci * br;
            cre[c] = a.in[I_CRE][((size_t)(dir * SG + g) * 16 + c) * SNS + lane]; cim[c] = a.in[I_CIM][((size_t)(dir * SG + g) * 16 + c) * SNS + lane]; }
        float xr = 0.f, xi = 0.f;
        const int cosel = ((lane >> 5) & 1) * 8 + ((lane >> 4) & 1) * 4 + ((lane >> 3) & 1) * 2 + ((lane >> 2) & 1);
        for (int step0 = 0; step0 < SEQ; step0 += 8) {
            v4u ub[8][2];
#pragma unroll
            for (int s8 = 0; s8 < 8; ++s8) {
                const int t = dir ? (SEQ - 1 - (step0 + s8)) : (step0 + s8); const size_t row = (size_t)b * SEQ + t;
                const v4u* up = (const v4u*)(UX + ((size_t)g * (TT / 16) + (row >> 4)) * 512 + (row & 15) * 16);
                ub[s8][0] = up[0]; ub[s8][1] = up[1];
            }
#pragma unroll
            for (int s8 = 0; s8 < 8; ++s8) {
            const int t = dir ? (SEQ - 1 - (step0 + s8)) : (step0 + s8); const size_t row = (size_t)b * SEQ + t;
            const v4u u0 = ub[s8][0], u1 = ub[s8][1];
            const float uu[16] = {bf_lo(u0.x), bf_hi(u0.x), bf_lo(u0.y), bf_hi(u0.y), bf_lo(u0.z), bf_hi(u0.z), bf_lo(u0.w), bf_hi(u0.w), bf_lo(u1.x), bf_hi(u1.x), bf_lo(u1.y), bf_hi(u1.y), bf_lo(u1.z), bf_hi(u1.z), bf_lo(u1.w), bf_hi(u1.w)};
            float bur = 0.f, bui = 0.f;
#pragma unroll
            for (int c = 0; c < 16; ++c) { bur += bbr[c] * uu[c]; bui += bbi[c] * uu[c]; }
            const float nxr = ar * xr - ai * xi + bur, nxi = ar * xi + ai * xr + bui; xr = nxr; xi = nxi;
            float p[16];
#pragma unroll
            for (int c = 0; c < 16; ++c) p[c] = cre[c] * xr - cim[c] * xi;
#pragma unroll
            for (int i = 0; i < 8; ++i) { const bool up_ = (lane & 32) != 0; const float send = up_ ? p[i] : p[i + 8], keep = up_ ? p[i + 8] : p[i]; p[i] = keep + __shfl_xor(send, 32); }
#pragma unroll
            for (int i = 0; i < 4; ++i) { const bool up_ = (lane & 16) != 0; const float send = up_ ? p[i] : p[i + 4], keep = up_ ? p[i + 4] : p[i]; p[i] = keep + __shfl_xor(send, 16); }
#pragma unroll
            for (int i = 0; i < 2; ++i) { const bool up_ = (lane & 8) != 0; const float send = up_ ? p[i] : p[i + 2], keep = up_ ? p[i + 2] : p[i]; p[i] = keep + __shfl_xor(send, 8); }
            { const bool up_ = (lane & 4) != 0; const float send = up_ ? p[0] : p[1], keep = up_ ? p[1] : p[0]; p[0] = keep + __shfl_xor(send, 4); }
            p[0] += __shfl_xor(p[0], 2); p[0] += __shfl_xor(p[0], 1);
            if ((lane & 3) == 0) YF[((size_t)dir * TT + row) * RW + g * 16 + cosel] = p[0];
            }
        }
    }
}
__device__ __forceinline__ void s5_combine(const Args& a, int G) {
    const bf16* UX = (const bf16*)(a.ws + WS_UX); bf16* YB = (bf16*)(a.ws + WS_YB); const float* YF = a.out; const float* Dk = a.in[I_SD];
    for (size_t i = (size_t)blockIdx.x * NTHREADS + threadIdx.x; i < (size_t)TT * (RW / 8); i += (size_t)G * NTHREADS) {
        const size_t row = i >> 6; const int c8 = (int)(i & 63) * 8, g = c8 >> 4, ci0 = c8 & 15;
        const v4u uw = *(const v4u*)(UX + ((size_t)g * (TT / 16) + (row >> 4)) * 512 + (row & 15) * 16 + ci0);
        const float uu[8] = {bf_lo(uw.x), bf_hi(uw.x), bf_lo(uw.y), bf_hi(uw.y), bf_lo(uw.z), bf_hi(uw.z), bf_lo(uw.w), bf_hi(uw.w)};
        const f32x4 f0 = *(const f32x4*)(YF + row * RW + c8), f1 = *(const f32x4*)(YF + row * RW + c8 + 4);
        const f32x4 b0 = *(const f32x4*)(YF + ((size_t)TT + row) * RW + c8), b1 = *(const f32x4*)(YF + ((size_t)TT + row) * RW + c8 + 4);
        float y[8];
#pragma unroll
        for (int j = 0; j < 4; ++j) { y[j] = gelu_tanh(Dk[c8 + j] * uu[j] + f0[j] + b0[j]); y[4 + j] = gelu_tanh(Dk[c8 + 4 + j] * uu[4 + j] + f1[j] + b1[j]); }
        *(v4u*)(YB + row * RW + c8) = (v4u){pk2(y[0], y[1]), pk2(y[2], y[3]), pk2(y[4], y[5]), pk2(y[6], y[7])};
    }
}
__device__ __forceinline__ void ffn_fixup(const Args& a, int G) {
    const bf16* ZB = (const bf16*)(a.ws + WS_ZB); bf16* ACT = (bf16*)(a.ws + WS_ACT); const float* cw = a.in[I_CONVW]; const float* cb = a.in[I_CONVB];
    constexpr int NBLK = TT / 128, CG = DFF / 8;
    const int gt = blockIdx.x * NTHREADS + threadIdx.x, NT = G * NTHREADS;
    const int cg = gt % CG, slot = gt / CG, nslot = NT / CG;
    if (slot >= nslot) return;
    const int c = cg * 8;
    float wv[3][8], wg[3][8], bv[8], bg[8];
#pragma unroll
    for (int t = 0; t < 3; ++t) { const f32x4 x0 = *(const f32x4*)(cw + t * NUP + c), x1 = *(const f32x4*)(cw + t * NUP + c + 4), y0 = *(const f32x4*)(cw + t * NUP + DFF + c), y1 = *(const f32x4*)(cw + t * NUP + DFF + c + 4);
#pragma unroll
        for (int j = 0; j < 4; ++j) { wv[t][j] = x0[j]; wv[t][4 + j] = x1[j]; wg[t][j] = y0[j]; wg[t][4 + j] = y1[j]; } }
    { const f32x4 x0 = *(const f32x4*)(cb + c), x1 = *(const f32x4*)(cb + c + 4), y0 = *(const f32x4*)(cb + DFF + c), y1 = *(const f32x4*)(cb + DFF + c + 4);
#pragma unroll
      for (int j = 0; j < 4; ++j) { bv[j] = x0[j]; bv[4 + j] = x1[j]; bg[j] = y0[j]; bg[4 + j] = y1[j]; } }
    for (int it = slot; it < NBLK * 2; it += nslot) {
        const int blk = it >> 1, e = it & 1;
        const bool seq_first = (blk & 15) == 0, seq_last = (blk & 15) == 15;
        const bf16 *zp, *zc, *zn; bool hp = true, hn = true; int row;
        if (e == 0) { row = blk * 128; zc = ZB + ((size_t)blk * 4 + 0) * NUP; zn = ZB + ((size_t)blk * 4 + 1) * NUP; hp = !seq_first; zp = hp ? ZB + ((size_t)(blk - 1) * 4 + 3) * NUP : zc; }
        else { row = blk * 128 + 127; zc = ZB + ((size_t)blk * 4 + 3) * NUP; zp = ZB + ((size_t)blk * 4 + 2) * NUP; hn = !seq_last; zn = hn ? ZB + ((size_t)(blk + 1) * 4 + 0) * NUP : zc; }
        const v4u pv = *(const v4u*)(zp + c), cv = *(const v4u*)(zc + c), nv = *(const v4u*)(zn + c);
        const v4u pg = *(const v4u*)(zp + DFF + c), cgv = *(const v4u*)(zc + DFF + c), ng = *(const v4u*)(zn + DFF + c);
        const float mp = hp ? 1.f : 0.f, mn = hn ? 1.f : 0.f;
        const unsigned pvw[4] = {pv.x, pv.y, pv.z, pv.w}, cvw[4] = {cv.x, cv.y, cv.z, cv.w}, nvw[4] = {nv.x, nv.y, nv.z, nv.w};
        const unsigned pgw[4] = {pg.x, pg.y, pg.z, pg.w}, cgw[4] = {cgv.x, cgv.y, cgv.z, cgv.w}, ngw[4] = {ng.x, ng.y, ng.z, ng.w};
        unsigned ow[4];
#pragma unroll
        for (int j2 = 0; j2 < 4; ++j2) {
            float r[2];
#pragma unroll
            for (int hlf = 0; hlf < 2; ++hlf) { const int j = 2 * j2 + hlf;
                const float fpv = (hlf ? bf_hi(pvw[j2]) : bf_lo(pvw[j2])) * mp, fcv = hlf ? bf_hi(cvw[j2]) : bf_lo(cvw[j2]), fnv = (hlf ? bf_hi(nvw[j2]) : bf_lo(nvw[j2])) * mn;
                const float fpg = (hlf ? bf_hi(pgw[j2]) : bf_lo(pgw[j2])) * mp, fcg = hlf ? bf_hi(cgw[j2]) : bf_lo(cgw[j2]), fng = (hlf ? bf_hi(ngw[j2]) : bf_lo(ngw[j2])) * mn;
                const float v = wv[0][j] * fpv + wv[1][j] * fcv + wv[2][j] * fnv + bv[j];
                const float gt_ = wg[0][j] * fpg + wg[1][j] * fcg + wg[2][j] * fng + bg[j];
                r[hlf] = gelu_tanh(gt_) * v; }
            ow[j2] = pk2(r[0], r[1]);
        }
        *(v4u*)(ACT + (size_t)row * DFF + c) = (v4u){ow[0], ow[1], ow[2], ow[3]};
    }
}
template <bool DRY> __device__ __forceinline__ void final_norm(const Args& a, int wave, int lane, int G) {
    const GAS f32x4* gn = (const GAS f32x4*)a.in[I_NFIN] + lane;
    f32x4 gv[4];
#pragma unroll
    for (int j = 0; j < 4; ++j) gv[j] = gn[64 * j];
    for (int m = blockIdx.x * NWAVES + wave; m < TT; m += G * NWAVES) {
        GAS f32x4* xr = (GAS f32x4*)(a.out + (size_t)m * DM) + lane;
        f32x4 v[4]; float s = 0.f;
#pragma unroll
        for (int j = 0; j < 4; ++j) { v[j] = xr[64 * j]; s += (v[j].x * v[j].x + v[j].y * v[j].y) + (v[j].z * v[j].z + v[j].w * v[j].w); }
        const float rinv = 1.0f / sqrtf(wave_sum(s) * (1.0f / DM) + EPS);
#pragma unroll
        for (int j = 0; j < 4; ++j) { const f32x4 o = v[j] * rinv * gv[j]; if (!DRY) xr[64 * j] = o; else asm volatile("" :: "v"(o)); }
    }
}


typedef float f32x2v __attribute__((ext_vector_type(2)));
__device__ __forceinline__ void s5_build(const Args& a, LAS unsigned char* lds, int unit, int nparts) {
    const int g = unit >> 3, part0 = unit & 7, tid = threadIdx.x;
    LAS f32x2v* apow = (LAS f32x2v*)lds;
    LAS f32x2v* Bb = apow + 2 * 17 * 64;
    LAS f32x2v* Cc = Bb + 2 * 64 * 16;
    LAS float* Kt = (LAS float*)(Cc + 2 * 16 * 64);
    LAS f32x2v* coefs = (LAS f32x2v*)(Kt + 2 * 16 * 16 * 16);
    if (tid < 128) {
        const int dir = tid >> 6, n = tid & 63, pidx = (dir * SG + g) * SNS + n;
        const float lr = fminf(a.in[I_LRE][pidx], -1e-4f), li = a.in[I_LIM][pidx], dt = expf(a.in[I_LDT][dir * SG + g]);
        const float mag = expf(lr * dt); float sn, cs; sincosf(li * dt, &sn, &cs);
        const float ar = mag * cs, ai = mag * sn;
        const float den = lr * lr + li * li, nr = ar - 1.0f, ni = ai;
        coefs[tid] = (f32x2v){(nr * lr + ni * li) / den, (ni * lr - nr * li) / den};
        float pr = 1.0f, pi = 0.0f;
        for (int j = 0; j < 17; ++j) { apow[(dir * 17 + j) * 64 + n] = (f32x2v){pr, pi}; const float qr = pr * ar - pi * ai, qi = pr * ai + pi * ar; pr = qr; pi = qi; }
    }
    __syncthreads();
    for (int idx = tid; idx < 2 * 64 * 16; idx += NTHREADS) {
        const int dir = idx >> 10, n = (idx >> 4) & 63, ci = idx & 15, pidx = (dir * SG + g) * SNS + n;
        const f32x2v cf = coefs[dir * 64 + n];
        const float br = a.in[I_BRE][(size_t)pidx * 16 + ci], bi = a.in[I_BIM][(size_t)pidx * 16 + ci];
        Bb[idx] = (f32x2v){cf.x * br - cf.y * bi, cf.x * bi + cf.y * br};
    }
    for (int idx = tid; idx < 2 * 16 * 64; idx += NTHREADS) {
        const int dir = idx >> 10, co = (idx >> 6) & 15, n = idx & 63; const size_t p = ((size_t)(dir * SG + g) * 16 + co) * SNS + n;
        Cc[idx] = (f32x2v){a.in[I_CRE][p], a.in[I_CIM][p]};
    }
    __syncthreads();
    {
        const int dir = tid >> 8, j = (tid >> 4) & 15, co = tid & 15;
        float acc[16];
#pragma unroll
        for (int ci = 0; ci < 16; ++ci) acc[ci] = 0.f;
        for (int n = 0; n < 64; ++n) {
            const f32x2v c = Cc[(dir * 16 + co) * 64 + n], p = apow[(dir * 17 + j) * 64 + n];
            const float m1r = c.x * p.x - c.y * p.y, m1i = c.x * p.y + c.y * p.x;
#pragma unroll
            for (int ci = 0; ci < 16; ++ci) { const f32x2v b = Bb[(dir * 64 + n) * 16 + ci]; acc[ci] += m1r * b.x - m1i * b.y; }
        }
#pragma unroll
        for (int ci = 0; ci < 16; ++ci) Kt[((dir * 16 + j) * 16 + co) * 16 + ci] = acc[ci];
    }
    __syncthreads();
    bf16* BtY = (bf16*)(a.ws + WS_BTY) + (size_t)g * 256 * 512; bf16* BtE = (bf16*)(a.ws + WS_BTE) + (size_t)g * 256 * 256;
    for (int part = part0; part < part0 + nparts; ++part) {
    for (int q = tid; q < 32 * 64; q += NTHREADS) {
        const int rr = q >> 6, ch = q & 63, i = 2 * part + (rr >> 4), co = rr & 15, row = i * 16 + co;
        float v[8];
        if (ch < 32) {
            const int sidx = ch >> 1;
#pragma unroll
            for (int e = 0; e < 8; ++e) { const int ci = (ch & 1) * 8 + e; float x;
                if (sidx < i) x = Kt[((0 * 16 + (i - sidx)) * 16 + co) * 16 + ci];
                else if (sidx > i) x = Kt[((1 * 16 + (sidx - i)) * 16 + co) * 16 + ci];
                else x = Kt[((0 * 16 + 0) * 16 + co) * 16 + ci] + Kt[((1 * 16 + 0) * 16 + co) * 16 + ci] + (co == ci ? a.in[I_SD][g * 16 + co] : 0.f);
                v[e] = x; }
        } else {
            const int jj0 = (ch - 32) * 8, dir = jj0 >> 7, n0 = (jj0 >> 1) & 63, pw = dir == 0 ? i + 1 : 16 - i;
#pragma unroll
            for (int t = 0; t < 4; ++t) { const f32x2v c = Cc[(dir * 16 + co) * 64 + n0 + t], p = apow[(dir * 17 + pw) * 64 + n0 + t];
                v[2 * t] = c.x * p.x - c.y * p.y; v[2 * t + 1] = -(c.x * p.y + c.y * p.x); }
        }
        *(GAS v4u*)(BtY + (size_t)row * 512 + ch * 8) = (v4u){pk2(v[0], v[1]), pk2(v[2], v[3]), pk2(v[4], v[5]), pk2(v[6], v[7])};
    }
    for (int q = tid; q < 32 * 32; q += NTHREADS) {
        const int rr = q >> 5, ch = q & 31, j = 32 * part + rr, dir = j >> 7, n = (j >> 1) & 63, ri = j & 1;
        const int sidx = ch >> 1, pw = dir == 0 ? 15 - sidx : sidx; const f32x2v p = apow[(dir * 17 + pw) * 64 + n];
        float v[8];
#pragma unroll
        for (int e = 0; e < 8; ++e) { const f32x2v b = Bb[(dir * 64 + n) * 16 + (ch & 1) * 8 + e]; v[e] = ri ? (p.x * b.y + p.y * b.x) : (p.x * b.x - p.y * b.y); }
        *(GAS v4u*)(BtE + (size_t)j * 256 + ch * 8) = (v4u){pk2(v[0], v[1]), pk2(v[2], v[3]), pk2(v[4], v[5]), pk2(v[6], v[7])};
    }
    }
    if (part0 == 0 && tid < 128) { const int dir = tid >> 6, n = tid & 63; ((GAS f32x2v*)(a.ws + WS_A16))[g * 128 + tid] = apow[(dir * 17 + 16) * 64 + n]; }
    __syncthreads();
}
struct S5Order {
    int G, c;
    __device__ __forceinline__ bool next(int i, Unit& u) const { const int L = i * G + c; if (L >= SG * 12) return false; u.pm = L; u.pn = L / 12; return true; }
    __device__ __forceinline__ void a_ready(const Unit&) const {}
    __device__ __forceinline__ void done(const Unit&) const {}
};
struct EpiE {
    static constexpr int NDEFER = 0; struct Carry {};
    bf16* E;
    __device__ __forceinline__ void operator()(const f32x4 (&acc)[2][2][4][2], const Unit& u, int wr, int wc, int fr, int fq) const {
        bf16* rp = E + (size_t)(u.pm * 256 + wr * 64 + fr) * 256 + wc * 32 + 8 * fq;
#pragma unroll
        for (int ai = 0; ai < 2; ++ai) {
#pragma unroll
            for (int m = 0; m < 4; ++m) {
#pragma unroll
                for (int bj = 0; bj < 2; ++bj) { const f32x4 v0 = acc[ai][bj][m][0], v1 = acc[ai][bj][m][1];
                    *(v4u*)(rp + bj * 128) = (v4u){cvt_pk_bf16(v0[0], v0[1]), cvt_pk_bf16(v0[2], v0[3]), cvt_pk_bf16(v1[0], v1[1]), cvt_pk_bf16(v1[2], v1[3])}; }
                rp += 16 * 256; asm volatile("" : "+v"(rp));
            }
            rp += 64 * 256; asm volatile("" : "+v"(rp));
        }
    }
};
struct EpiY {
    static constexpr int NDEFER = 0; struct Carry {};
    bf16* YB;
    __device__ __forceinline__ void operator()(const f32x4 (&acc)[2][2][4][2], const Unit& u, int wr, int wc, int fr, int fq) const {
        const int g = u.pn, crow0 = (u.pm - g * 12) * 256 + wr * 64 + fr;
#pragma unroll
        for (int ai = 0; ai < 2; ++ai)
#pragma unroll
            for (int m = 0; m < 4; ++m) {
                const int crow = crow0 + ai * 128 + m * 16;
#pragma unroll
                for (int bj = 0; bj < 2; ++bj) {
                    const int i = 8 * bj + 2 * wc + (fq >> 1);
                    const f32x4 v0 = gelu4(acc[ai][bj][m][0]), v1 = gelu4(acc[ai][bj][m][1]);
                    v4u w; w.x = cvt_pk_bf16(v0[0], v0[1]); w.y = cvt_pk_bf16(v0[2], v0[3]); w.z = cvt_pk_bf16(v1[0], v1[1]); w.w = cvt_pk_bf16(v1[2], v1[3]);
                    *(v4u*)(YB + ((size_t)g * TT + (size_t)crow * 16 + i) * 16 + 8 * (fq & 1)) = w;
                }
            }
    }
};
__device__ __forceinline__ void s5_scan(const Args& a, int wg, int nwg) {
    const bf16* E = (const bf16*)a.out; bf16* UX = (bf16*)(a.ws + WS_UX);
    constexpr int NREC = SG * NSEQ * 128, NC = 3;
    for (int base = wg * NTHREADS + threadIdx.x; base < NREC; base += NC * nwg * NTHREADS) {
        f32x2v a16[NC]; size_t row0[NC]; int col[NC], dirv[NC]; float xr[NC], xi[NC]; bool on[NC];
#pragma unroll
        for (int c = 0; c < NC; ++c) {
            const int idx = base + c * nwg * NTHREADS; on[c] = idx < NREC; const int id = on[c] ? idx : base;
            const int n = id & 63, dir = (id >> 6) & 1, gb = id >> 7, b = gb % NSEQ, g = gb / NSEQ;
            a16[c] = ((const f32x2v*)(a.ws + WS_A16))[g * 128 + dir * 64 + n];
            row0[c] = (size_t)g * (TT / 16) + (size_t)b * 128; col[c] = dir * 128 + 2 * n; dirv[c] = dir; xr[c] = 0.f; xi[c] = 0.f;
        }
        for (int k0 = 0; k0 < 128; k0 += 8) {
            unsigned ew[NC][8];
#pragma unroll
            for (int c = 0; c < NC; ++c)
#pragma unroll
                for (int s8 = 0; s8 < 8; ++s8) { const int k = dirv[c] ? 127 - (k0 + s8) : (k0 + s8); ew[c][s8] = *(const unsigned*)(E + (row0[c] + k) * 256 + col[c]); }
#pragma unroll
            for (int c = 0; c < NC; ++c)
#pragma unroll
                for (int s8 = 0; s8 < 8; ++s8) { const int k = dirv[c] ? 127 - (k0 + s8) : (k0 + s8);
                    if (on[c]) *(unsigned*)(UX + (row0[c] + k) * 512 + 256 + col[c]) = pk2(xr[c], xi[c]);
                    const float nxr = a16[c].x * xr[c] - a16[c].y * xi[c] + bf_lo(ew[c][s8]), nxi = a16[c].x * xi[c] + a16[c].y * xr[c] + bf_hi(ew[c][s8]); xr[c] = nxr; xi[c] = nxi; }
        }
    }
}

typedef float f32x16 __attribute__((ext_vector_type(16)));
typedef short bf16x8v __attribute__((ext_vector_type(8)));
typedef short s16x4v __attribute__((ext_vector_type(4)));
#define MFMA32(a, b, c) __builtin_amdgcn_mfma_f32_32x32x16_bf16((a), (b), (c), 0, 0, 0)
constexpr size_t OUT_R_OFF = 96 * MiB;
constexpr int RT0 = 0, RT1 = 32768, RT2 = 65536, RT3 = 98304;
__device__ __forceinline__ int off_row(int row, int chunk) { return row * 256 + ((chunk ^ (row & 15)) << 4); }
__device__ __forceinline__ int off_tr(int row, int colbyte) { return row * 256 + (colbyte ^ ((row & 3) << 6)); }
__device__ __forceinline__ s16x4v tr_rd(LAS unsigned char* p) { return __builtin_bit_cast(s16x4v, __builtin_amdgcn_ds_read_tr16_b64_v4i16((LAS s16x4v*)p)); }
__device__ __forceinline__ unsigned cvtpk(float lo, float hi) { typedef float f2 __attribute__((ext_vector_type(2))); typedef __bf16 b2 __attribute__((ext_vector_type(2))); f2 v = {lo, hi}; b2 b = __builtin_convertvector(v, b2); return __builtin_bit_cast(unsigned, b); }
__device__ __forceinline__ v4u scale8(v4u w, float sc) {
    return (v4u){cvtpk(bf_lo(w.x) * sc, bf_hi(w.x) * sc), cvtpk(bf_lo(w.y) * sc, bf_hi(w.y) * sc), cvtpk(bf_lo(w.z) * sc, bf_hi(w.z) * sc), cvtpk(bf_lo(w.w) * sc, bf_hi(w.w) * sc)};
}
__device__ __forceinline__ void ret_state(const Args& a, LAS unsigned char* lds, int unit) {
    const int tid = threadIdx.x, lane = tid & 63, w = __builtin_amdgcn_readfirstlane(tid >> 6), r = lane & 31, hh = lane >> 5, g1 = (lane >> 4) & 1, ip = lane & 15;
    const int dir = unit & 1, head = (unit >> 1) & 3, b = unit >> 3;
    const float lg2 = log2f(1.0f - exp2f(-5.0f - (float)head)), gC = exp2f(lg2 * 128.0f);
    const bf16* Kg = (const bf16*)(a.ws + WS_K) + (size_t)b * SEQ * RW + head * DH; const bf16* Vg = (const bf16*)(a.ws + WS_V) + (size_t)b * SEQ * RW + head * DH;
    bf16* Rg = (bf16*)((unsigned char*)a.out + OUT_R_OFF) + (size_t)((b * NHEAD + head) * 16) * 2 * 16384 + (size_t)dir * 16384;
    const int eb = w & 3, dh2 = w >> 2;
    f32x16 acc[2];
#pragma unroll
    for (int i = 0; i < 16; ++i) { acc[0][i] = 0.f; acc[1][i] = 0.f; }
    v4u kreg[4], vreg[4];
    {
        const int n0 = dir ? 15 : 0;
#pragma unroll
        for (int i = 0; i < 4; ++i) { const int q = tid + NTHREADS * i, row = q >> 4, ch = q & 15; kreg[i] = __builtin_nontemporal_load((const v4u*)(Kg + (size_t)(n0 * 128 + row) * RW + ch * 8)); vreg[i] = __builtin_nontemporal_load((const v4u*)(Vg + (size_t)(n0 * 128 + row) * RW + ch * 8)); }
    }
    for (int step = 0; step < 16; ++step) {
        const int n = dir ? 15 - step : step;
        if (step < 15) {
#pragma unroll
        for (int i = 0; i < 4; ++i) { const int q = tid + NTHREADS * i, row = q >> 4, ch = q & 15;
            const float sc = exp2f(lg2 * (float)(dir ? row : 127 - row));
            *(LAS v4u*)(lds + RT0 + off_tr(row, ch * 16)) = scale8(kreg[i], sc);
            *(LAS v4u*)(lds + RT1 + off_tr(row, ch * 16)) = vreg[i]; }
        }
        if (step < 14) { const int nn = dir ? n - 1 : n + 1;
#pragma unroll
            for (int i = 0; i < 4; ++i) { const int q = tid + NTHREADS * i, row = q >> 4, ch = q & 15; kreg[i] = __builtin_nontemporal_load((const v4u*)(Kg + (size_t)(nn * 128 + row) * RW + ch * 8)); vreg[i] = __builtin_nontemporal_load((const v4u*)(Vg + (size_t)(nn * 128 + row) * RW + ch * 8)); } }
        if (step > 0) {
            bf16* Rn = Rg + (size_t)n * 2 * 16384;
#pragma unroll
            for (int dbi = 0; dbi < 2; ++dbi)
#pragma unroll
                for (int i = 0; i < 16; ++i) {
                    const float mine = acc[dbi][i];
                    const float other = __builtin_bit_cast(float, __builtin_amdgcn_update_dpp(0, __builtin_bit_cast(int, mine), 0xB1, 0xf, 0xf, false));
                    if ((lane & 1) == 0) { const int e = 32 * eb + (i & 3) + 8 * (i >> 2) + 4 * hh; *(unsigned*)(Rn + (size_t)e * 128 + 32 * (2 * dh2 + dbi) + r) = cvtpk(mine, other); }
                }
        }
        if (step == 15) break;
#pragma unroll
        for (int i = 0; i < 16; ++i) { acc[0][i] *= gC; acc[1][i] *= gC; }
        __syncthreads();
#pragma unroll
        for (int s = 0; s < 8; ++s) {
            const int m0 = 16 * s + 8 * hh + (ip >> 2);
            const int cbV = (32 * eb + 16 * g1 + 4 * (ip & 3)) * 2;
            const s16x4v v0 = tr_rd(lds + RT1 + off_tr(m0, cbV)), v1 = tr_rd(lds + RT1 + off_tr(m0 + 4, cbV));
            const bf16x8v vb = (bf16x8v){v0[0], v0[1], v0[2], v0[3], v1[0], v1[1], v1[2], v1[3]};
#pragma unroll
            for (int dbi = 0; dbi < 2; ++dbi) {
                const int cbK = (32 * (2 * dh2 + dbi) + 16 * g1 + 4 * (ip & 3)) * 2;
                const s16x4v k0 = tr_rd(lds + RT0 + off_tr(m0, cbK)), k1 = tr_rd(lds + RT0 + off_tr(m0 + 4, cbK));
                const bf16x8v ka = (bf16x8v){k0[0], k0[1], k0[2], k0[3], k1[0], k1[1], k1[2], k1[3]};
                acc[dbi] = MFMA32(vb, ka, acc[dbi]);
            }
        }
        __syncthreads();
    }
    __syncthreads();
}
struct RetPtrs { const bf16 *Qg, *Kg, *Vg, *Rf; };
__device__ __forceinline__ RetPtrs ret_ptrs(const Args& a, int unit) {
    const int n = unit & 15, head = (unit >> 4) & 3, b = unit >> 6;
    const size_t tok0 = (size_t)b * SEQ + (size_t)n * 128;
    RetPtrs p; p.Qg = (const bf16*)(a.ws + WS_Q) + tok0 * RW + head * DH; p.Kg = (const bf16*)(a.ws + WS_K) + tok0 * RW + head * DH; p.Vg = (const bf16*)(a.ws + WS_V) + tok0 * RW + head * DH;
    p.Rf = (const bf16*)((const unsigned char*)a.out + OUT_R_OFF) + (size_t)((b * NHEAD + head) * 16 + n) * 2 * 16384; return p;
}
__device__ __forceinline__ void ret_out_all(const Args& a, LAS unsigned char* lds, int first, int stride, int nunits) {
    const int tid_ = threadIdx.x, lane = tid_ & 63, w = __builtin_amdgcn_readfirstlane(tid_ >> 6), r_ = lane & 31, hh = lane >> 5, g1 = (lane >> 4) & 1, ip_ = lane & 15;
    const int cb = w & 3, half = w >> 2, c_ = 32 * cb + r_;
    if (first >= nunits) return;
    v4u kreg[4], vreg[4], freg[4], breg[4];
#define RET_FETCH(unit_, tid, r) do { const RetPtrs p_ = ret_ptrs(a, (unit_)); \
        _Pragma("unroll") for (int i = 0; i < 4; ++i) { const int q = tid + NTHREADS * i, row = q >> 4, ch = q & 15; \
            kreg[i] = __builtin_nontemporal_load((const v4u*)(p_.Kg + (size_t)row * RW + ch * 8)); vreg[i] = __builtin_nontemporal_load((const v4u*)(p_.Vg + (size_t)row * RW + ch * 8)); \
            freg[i] = ((unit_) & 15) == 0 ? (v4u){0u, 0u, 0u, 0u} : __builtin_nontemporal_load((const v4u*)(p_.Rf + row * 128 + ch * 8)); \
            breg[i] = ((unit_) & 15) == 15 ? (v4u){0u, 0u, 0u, 0u} : __builtin_nontemporal_load((const v4u*)(p_.Rf + 16384 + row * 128 + ch * 8)); } } while (0)
    RET_FETCH(first, tid_, r_);
    for (int unit = first; unit < nunits; unit += stride) {
        const int n = unit & 15, head = (unit >> 4) & 3, b = unit >> 6;
        const float lg2 = log2f(1.0f - exp2f(-5.0f - (float)head));
        const size_t tok0 = (size_t)b * SEQ + (size_t)n * 128;
        int tid = tid_, r = r_, ip = ip_, c = c_;
        asm volatile("" : "+v"(tid), "+v"(r), "+v"(ip), "+v"(c));
        bf16x8v qf[8];
        { const bf16* Qg = (const bf16*)(a.ws + WS_Q) + tok0 * RW + head * DH;
#pragma unroll
          for (int s = 0; s < 8; ++s) qf[s] = *(const bf16x8v*)(Qg + (size_t)(32 * cb + r) * RW + 16 * s + 8 * hh); }
#pragma unroll
        for (int i = 0; i < 4; ++i) { const int q = tid + NTHREADS * i, row = q >> 4, ch = q & 15;
            *(LAS v4u*)(lds + RT0 + off_row(row, ch)) = kreg[i]; *(LAS v4u*)(lds + RT1 + off_tr(row, ch * 16)) = vreg[i];
            *(LAS v4u*)(lds + RT2 + off_row(row, ch)) = freg[i]; *(LAS v4u*)(lds + RT3 + off_row(row, ch)) = breg[i]; }
        __syncthreads();
        f32x16 O[4];
        {
            const int Rt = half ? RT3 : RT2;
            const float sc = exp2f(lg2 * (float)(half ? 128 - c : c + 1));
#pragma unroll
            for (int eb = 0; eb < 4; ++eb) {
#pragma unroll
                for (int i = 0; i < 16; ++i) O[eb][i] = 0.f;
#pragma unroll
                for (int s = 0; s < 8; ++s) { const bf16x8v rf = *(const LAS bf16x8v*)(lds + Rt + off_row(32 * eb + r, 2 * s + hh)); O[eb] = MFMA32(rf, qf[s], O[eb]); }
#pragma unroll
                for (int i = 0; i < 16; ++i) O[eb][i] *= sc;
            }
        }
        bf16x8v pb[2][2];
#pragma unroll
        for (int mbi = 0; mbi < 2; ++mbi) {
            const int mb = 2 * half + mbi;
            f32x16 S;
#pragma unroll
            for (int i = 0; i < 16; ++i) S[i] = 0.f;
#pragma unroll
            for (int s = 0; s < 8; ++s) { const bf16x8v kf = *(const LAS bf16x8v*)(lds + RT0 + off_row(32 * mb + r, 2 * s + hh)); S = MFMA32(kf, qf[s], S); }
#pragma unroll
            for (int i = 0; i < 16; ++i) { const int m = 32 * mb + (i & 3) + 8 * (i >> 2) + 4 * hh; const int dist = c > m ? c - m : m - c; S[i] *= exp2f(lg2 * (float)dist); }
#pragma unroll
            for (int s2 = 0; s2 < 2; ++s2) {
                const v4u p = (v4u){cvtpk(S[8 * s2], S[8 * s2 + 1]), cvtpk(S[8 * s2 + 2], S[8 * s2 + 3]), cvtpk(S[8 * s2 + 4], S[8 * s2 + 5]), cvtpk(S[8 * s2 + 6], S[8 * s2 + 7])};
                pb[mbi][s2] = __builtin_bit_cast(bf16x8v, p);
            }
        }
#pragma unroll
        for (int eb = 0; eb < 4; ++eb) {
            const int cbV = (32 * eb + 16 * g1 + 4 * (ip & 3)) * 2;
#pragma unroll
            for (int mbi = 0; mbi < 2; ++mbi)
#pragma unroll
                for (int s2 = 0; s2 < 2; ++s2) {
                    const int t0 = 32 * (2 * half + mbi) + 16 * s2 + 4 * hh + (ip >> 2);
                    const s16x4v v0 = tr_rd(lds + RT1 + off_tr(t0, cbV)), v1 = tr_rd(lds + RT1 + off_tr(t0 + 8, cbV));
                    const bf16x8v va = (bf16x8v){v0[0], v0[1], v0[2], v0[3], v1[0], v1[1], v1[2], v1[3]};
                    O[eb] = MFMA32(va, pb[mbi][s2], O[eb]);
                }
        }
        __syncthreads();
        if (unit + stride < nunits) RET_FETCH(unit + stride, tid, r);
        v4u gpre[4];
#pragma unroll
        for (int it = 0; it < 4; ++it) { const int q = tid + NTHREADS * it, row = q >> 4, ch = q & 15;
            gpre[it] = __builtin_nontemporal_load((const v4u*)((const bf16*)(a.ws + WS_G) + (tok0 + row) * RW + head * DH + ch * 8)); }
        LAS float* Xch = (LAS float*)lds;
        if (half == 1) {
#pragma unroll
            for (int eb = 0; eb < 4; ++eb)
#pragma unroll
                for (int i = 0; i < 16; ++i) Xch[((w & 3) * 64 + eb * 16 + i) * 64 + lane] = O[eb][i];
        }
        __syncthreads();
        LAS unsigned char* Ob = lds + 65536;
        LAS float* rnv = (LAS float*)(lds + 65536 + 32768);
        if (half == 0) {
            float ss = 0.f;
#pragma unroll
            for (int eb = 0; eb < 4; ++eb)
#pragma unroll
                for (int i = 0; i < 16; ++i) { O[eb][i] += Xch[(w * 64 + eb * 16 + i) * 64 + lane]; ss += O[eb][i] * O[eb][i]; }
            ss += __shfl_xor(ss, 32);
            if (hh == 0) rnv[c] = 1.0f / sqrtf(ss * (1.0f / DH) + EPS);
#pragma unroll
            for (int eb = 0; eb < 4; ++eb)
#pragma unroll
                for (int rg = 0; rg < 4; ++rg) { const int e0 = 32 * eb + 8 * rg + 4 * hh;
                    *(LAS v2u*)(Ob + c * 256 + ((((e0 >> 3) ^ (c & 15)) << 4) | ((e0 & 4) << 1))) = (v2u){cvtpk(O[eb][4 * rg], O[eb][4 * rg + 1]), cvtpk(O[eb][4 * rg + 2], O[eb][4 * rg + 3])}; }
        }
        __syncthreads();
        {
            const float* gn = a.in[I_GN] + head * DH;
#pragma unroll
            for (int it = 0; it < 4; ++it) { const int q = tid + NTHREADS * it, row = q >> 4, ch = q & 15;
                const v4u ow = *(const LAS v4u*)(Ob + row * 256 + ((ch ^ (row & 15)) << 4));
                const v4u gw = gpre[it];
                const f32x4 ga = *(const f32x4*)(gn + ch * 8), gb = *(const f32x4*)(gn + ch * 8 + 4);
                const float rn = rnv[row];
                const float g0 = bf_lo(gw.x), g1_ = bf_hi(gw.x), g2 = bf_lo(gw.y), g3 = bf_hi(gw.y), g4 = bf_lo(gw.z), g5 = bf_hi(gw.z), g6 = bf_lo(gw.w), g7 = bf_hi(gw.w);
                v4u o;
                o.x = cvtpk(g0 * sigmoidf_(g0) * ga[0] * rn * bf_lo(ow.x), g1_ * sigmoidf_(g1_) * ga[1] * rn * bf_hi(ow.x));
                o.y = cvtpk(g2 * sigmoidf_(g2) * ga[2] * rn * bf_lo(ow.y), g3 * sigmoidf_(g3) * ga[3] * rn * bf_hi(ow.y));
                o.z = cvtpk(g4 * sigmoidf_(g4) * gb[0] * rn * bf_lo(ow.z), g5 * sigmoidf_(g5) * gb[1] * rn * bf_hi(ow.z));
                o.w = cvtpk(g6 * sigmoidf_(g6) * gb[2] * rn * bf_lo(ow.w), g7 * sigmoidf_(g7) * gb[3] * rn * bf_hi(ow.w));
                *(v4u*)((bf16*)a.out + (tok0 + row) * DM + head * DH + ch * 8) = o; }
        }
        __syncthreads();
    }
#undef RET_FETCH
}

__global__ void __launch_bounds__(NTHREADS, 2) hybrid_fwd(Args args) {
    extern __shared__ __attribute__((aligned(16))) unsigned char lds[];
    LAS unsigned char* L = (LAS unsigned char*)lds;
    volatile LAS unsigned* MISC = (volatile LAS unsigned*)(L + MISC_OFF);
    const int tid = threadIdx.x, lane = tid & 63, wave = __builtin_amdgcn_readfirstlane(tid >> 6);
    const int G = gridDim.x; const int bx = blockIdx.x; const int vcu = (G % 8 == 0) ? (bx % 8) * (G / 8) + bx / 8 : bx;
    unsigned char* ws = args.ws;
    for (int u = tid; u < (LDS_BYTES - LDSCTL_OFF) / 4; u += NTHREADS) ((LAS unsigned*)(L + LDSCTL_OFF))[u] = 0u;
    __syncthreads();
    XcdBarrier bar; bar.bar = (unsigned*)(ws + WS_CTL) + CW_BAR; bar.x = 0; bar.st = nullptr;
    if (N_LAUNCHES == 1) bar = xcd_barrier_post((unsigned*)(ws + WS_CTL) + CW_BAR, MISC + 8);
    const int lo = args.ph_lo, hi = args.ph_hi;
#ifndef MK_PHASE_MASK
#define MK_PHASE_MASK 0x3ff
#endif
#define IN(k) (((MK_PHASE_MASK >> (k)) & 1) && lo <= (k) && (k) < hi)
#define SEAM(k) do { if (IN(k) && IN((k) + 1)) xcd_barrier(bar); } while (0)

#ifndef MK_REPEAT_MASK
#define MK_REPEAT_MASK 0
#endif
#define NREP(k) (((MK_REPEAT_MASK >> (k)) & 1) ? 2 : 1)
#define RUN(k, BODY) do { if (IN(k)) { if (NREP(k) == 2) { BODY; xcd_barrier(bar); } BODY; } } while (0)
#define BODY0 { p0_prologue(args, L, wave, lane, vcu, G); }
#define BODY1 { pg8::Gemm g{(const bf16*)(ws + WS_H1), (const bf16*)(ws + WS_WIN), TT, INW, DM, DM, DM, true}; \
        EpiIn E{(bf16*)(ws + WS_Q), (bf16*)(ws + WS_K), (bf16*)(ws + WS_V), (bf16*)(ws + WS_G), (bf16*)(ws + WS_UX), (const float*)(ws + WS_ROT), (const float*)(ws + WS_ROT) + SEQ * 64}; \
        if (G == 256) { P1Order S; S.init(G, bx, (unsigned*)(ws + WS_CTL) + CW_UXRDY); pg8::gemm_phase<EpiIn, P1Order, true>(L, g, S, E); \
            if (bx >= 128) { pg8::Gemm g2{(const bf16*)(ws + WS_UX), (const bf16*)(ws + WS_BTE), SG * (TT / 16), 256, 256, 512, 256}; S5ESubOrder S2{128, bx - 128, (const unsigned*)(ws + WS_CTL) + CW_UXRDY}; EpiE E2{(bf16*)args.out}; \
                pg8::gemm_phase<EpiE, S5ESubOrder, true, false, 2>(L, g2, S2, E2); } } \
        else { pg8::StaticOrder S; S.init(TT, INW, G, bx, MK_WGM1); pg8::gemm_phase<EpiIn, pg8::StaticOrder, true>(L, g, S, E); } }
#define BODY2 { if (G != 256) { \
        pg8::Gemm g{(const bf16*)(ws + WS_UX), (const bf16*)(ws + WS_BTE), SG * (TT / 16), 256, 256, 512, 256}; S5Order S{G, bx}; EpiE E{(bf16*)args.out}; \
        pg8::gemm_phase<EpiE, S5Order, true>(L, g, S, E); } }
#define BODY3 { if (G >= 256) { if (bx < NSEQ * NHEAD * 2) ret_state(args, L, bx); else s5_scan(args, bx - NSEQ * NHEAD * 2, G - NSEQ * NHEAD * 2); } \
        else { for (int un = bx; un < NSEQ * NHEAD * 2; un += G) ret_state(args, L, un); s5_scan(args, bx, G); } }
#define S5Y_ALL { pg8::Gemm g{(const bf16*)(ws + WS_UX), (const bf16*)(ws + WS_BTY), SG * (TT / 16), 256, 512, 512, 512}; S5Order S{G, bx}; EpiY E{(bf16*)(ws + WS_YB)}; \
        pg8::gemm_phase<EpiY, S5Order, true, false, 2>(L, g, S, E); }
#define BODY4 { if (G == 256) { if (bx < 128) { S5Y_ALL ret_out_all(args, L, bx, 128, 640); }        \
                                else { ret_out_all(args, L, 640 + (bx - 128), 128, NSEQ * NHEAD * 16); S5Y_ALL } } \
        else { ret_out_all(args, L, bx, G, NSEQ * NHEAD * 16); S5Y_ALL } }
#define BODY5 { pg8::Gemm g{(const bf16*)(ws + WS_YB), (const bf16*)(ws + WS_WGLU), TT, RW, RW, RW, RW, true, true}; pg8::StaticOrder S; S.init(TT, RW, G, bx, MK_WGM5); \
        EpiGlu E{(const bf16*)(ws + WS_YB), args.in[I_GLUB], (bf16*)args.out}; pg8::gemm_phase<EpiGlu, pg8::StaticOrder, true>(L, g, S, E); }
#define BODY6(DRY) { pg8::Gemm g{(const bf16*)args.out, (const bf16*)(ws + WS_WOUT), TT, DM, DM, DM, DM, true}; pg8::StaticOrder S; S.init(TT, DM, G, bx, MK_WGM6); \
        EpiOutT<DRY> E{(const bf16*)(ws + WS_H1), (const float*)(ws + WS_RMS1), args.in[I_NMIX], (bf16*)(ws + WS_X2B), (float*)(ws + WS_SS1)}; pg8::gemm_phase<EpiOutT<DRY>, pg8::StaticOrder, true>(L, g, S, E); }
#define BODY7 { pg8::Gemm g{(const bf16*)(ws + WS_X2B), (const bf16*)(ws + WS_WUP), TT, NUP, DM, DM, DM, true}; pg8::StaticOrder S; S.init(TT, NUP, G, bx, MK_WGM7); \
        EpiUp E{(bf16*)(ws + WS_ACT), (bf16*)(ws + WS_ZB), (const float*)(ws + WS_SS1), args.in[I_CONVW], args.in[I_CONVB]}; pg8::gemm_phase<EpiUp, pg8::StaticOrder, true, true>(L, g, S, E); }
#define BODY8 { ffn_fixup(args, G); }
#define BODY9 { pg8::Gemm g{(const bf16*)(ws + WS_ACT), (const bf16*)(ws + WS_WDN), TT, DM, DFF, DFF, DFF, true}; pg8::StaticOrder S; S.init(TT, DM, G, bx, MK_WGM9); \
        EpiDownNorm E{args.out, (const bf16*)(ws + WS_X2B), (float*)(ws + WS_SS2), (unsigned*)(ws + WS_CTL) + CW_PANEL, args.in[I_NFIN]}; pg8::gemm_phase<EpiDownNorm, pg8::StaticOrder, true>(L, g, S, E); }
    RUN(0, BODY0); SEAM(0);
    RUN(1, BODY1); SEAM(1);
    RUN(2, BODY2); if (G != 256) SEAM(2);
    RUN(3, BODY3); SEAM(3);
    RUN(4, BODY4); SEAM(4);
    RUN(5, BODY5); if (IN(5) && G == 256 && bx >= 128) late_weights(args, L, 0, bx - 128, 128, wave, lane); SEAM(5);
    if (IN(6)) { if (NREP(6) == 2) { BODY6(true); xcd_barrier(bar); } BODY6(false); } SEAM(6);
    RUN(7, BODY7); if (IN(7) && G == 256 && bx >= 128) late_weights(args, L, 1, bx - 128, 128, wave, lane); SEAM(7);
    RUN(8, BODY8); SEAM(8);
    if (IN(9)) BODY9;
#undef IN
#undef SEAM
}

extern "C" void kernel_launch(void* const* d_in, const int* in_sizes, int n_in, void* d_out, int out_size, void* d_ws, size_t ws_size, hipStream_t stream) {
    static int grid = 0;
    if (grid == 0) {
        if (n_in != 22 || out_size != TT * DM || ws_size < WS_END) { fprintf(stderr, "kernel_launch: unexpected shapes (n_in %d out %d ws %zu, need ws >= %zu)\n", n_in, out_size, ws_size, (size_t)WS_END); grid = -1; return; }
        int dev = 0, cus = 0, per_cu = 0;
        if (hipGetDevice(&dev) != hipSuccess || hipDeviceGetAttribute(&cus, hipDeviceAttributeMultiprocessorCount, dev) != hipSuccess) { grid = -1; return; }
        if (hipFuncSetAttribute((const void*)hybrid_fwd, hipFuncAttributeMaxDynamicSharedMemorySize, LDS_BYTES) != hipSuccess) { fprintf(stderr, "kernel_launch: hipFuncSetAttribute failed\n"); grid = -1; return; }
        if (hipOccupancyMaxActiveBlocksPerMultiprocessor(&per_cu, (const void*)hybrid_fwd, NTHREADS, LDS_BYTES) != hipSuccess || per_cu < 1)
            fprintf(stderr, "kernel_launch: occupancy query reports %d workgroups per CU\n", per_cu);
        (void)hipGetLastError();
        grid = cus;
    }
    if (grid < 0) return;
    if (hipMemsetAsync((char*)d_ws + WS_CTL, 0, CTL_ZERO_BYTES, stream) != hipSuccess) { fprintf(stderr, "kernel_launch: memset failed\n"); return; }
    Args a{};
    for (int i = 0; i < 22; ++i) a.in[i] = (const float*)d_in[i];
    a.out = (float*)d_out; a.ws = (unsigned char*)d_ws;
    if (N_LAUNCHES == 1) { a.ph_lo = 0; a.ph_hi = N_PHASES; hipLaunchKernelGGL(hybrid_fwd, dim3(grid), dim3(NTHREADS), LDS_BYTES, stream, a); }
    else for (int p = 0; p < N_PHASES; ++p) { a.ph_lo = p; a.ph_hi = p + 1; hipLaunchKernelGGL(hybrid_fwd, dim3(grid), dim3(NTHREADS), LDS_BYTES, stream, a); }
}
```
